# Optimizing an MI355X kernel written in HIP

```python
import jax, jax.numpy as jnp
from jax import lax
import numpy as np

D_MODEL = 1024
BATCH = 4
SEQ = 8192
DEPTH = 2

CHUNK = 64
QBLOCK = 128
N_A = DEPTH // 2
N_B = DEPTH - N_A
FOX_HEADS = 16
FOX_HEAD_DIM = 64
FOX_WIDTH = FOX_HEADS * FOX_HEAD_DIM
MLA_HEADS = 16
MLA_NOPE = 128
MLA_ROPE = 64
MLA_V = 128
KV_LORA = 256
Q_LORA = 768
ROPE_THETA = 10000.0
D_FF = 2816
CONV_W = 3
EPS = 1e-6

kernel_name = 'hybrid_fox_mla_yoco_convffn'


def rmsnorm(x, g):
    xf = x.astype(jnp.float32)
    y = xf * lax.rsqrt(jnp.mean(xf * xf, axis=-1, keepdims=True) + EPS)
    return (y * g.astype(jnp.float32)).astype(x.dtype)


def rope_tables(seq, dtype):
    pos = jnp.arange(seq, dtype=jnp.float32)
    inv = ROPE_THETA ** (-jnp.arange(0, MLA_ROPE, 2, dtype=jnp.float32) / MLA_ROPE)
    ang = pos[:, None] * inv[None, :]
    return jnp.cos(ang).astype(dtype), jnp.sin(ang).astype(dtype)


def apply_rope(x, cos, sin):
    x1, x2 = jnp.split(x, 2, axis=-1)
    return jnp.concatenate([x1 * cos - x2 * sin, x1 * sin + x2 * cos], axis=-1)


def to_blocks(a):
    b, s = a.shape[:2]
    a = a.reshape((b, s // QBLOCK, QBLOCK) + a.shape[2:])
    return jnp.moveaxis(a, 1, 0)


def from_blocks(a):
    a = jnp.moveaxis(a, 0, 1)
    return a.reshape((a.shape[0], a.shape[1] * a.shape[2]) + a.shape[3:])


def fox_mixer(h, w_in, b_f, w_out):
    b, s_len, _ = h.shape
    proj = h @ w_in
    qkv = proj[..., :3 * FOX_WIDTH].reshape(b, s_len, 3, FOX_HEADS, FOX_HEAD_DIM)
    q, k, v = qkv[:, :, 0], qkv[:, :, 1], qkv[:, :, 2]
    logf = jax.nn.log_sigmoid((proj[..., 3 * FOX_WIDTH:] + b_f).astype(jnp.float32))
    cum = jnp.cumsum(logf, axis=1)
    cum_k = jnp.transpose(cum, (0, 2, 1))
    kpos = jnp.arange(s_len)
    scale = FOX_HEAD_DIM ** -0.5

    def block(args):
        i, qi, ci = args
        sc = jnp.einsum('bqhd,bkhd->bhqk', qi, k, preferred_element_type=jnp.float32) * scale
        sc = sc + (jnp.transpose(ci, (0, 2, 1))[..., :, None] - cum_k[:, :, None, :])
        qpos = i * QBLOCK + jnp.arange(QBLOCK)
        sc = jnp.where(kpos[None, :] <= qpos[:, None], sc, -jnp.inf)
        p = jax.nn.softmax(sc, axis=-1).astype(v.dtype)
        return jnp.einsum('bhqk,bkhd->bqhd', p, v)

    o = lax.map(block, (jnp.arange(s_len // QBLOCK), to_blocks(q), to_blocks(cum)))
    return from_blocks(o).reshape(b, s_len, FOX_WIDTH) @ w_out


def mla_shared_kv(x, kv_in_g, w_dkv, kv_norm_g, w_uk, w_uv, cos, sin):
    b, s_len, _ = x.shape
    ckv = rmsnorm(x, kv_in_g) @ w_dkv
    latent = rmsnorm(ckv[..., :KV_LORA], kv_norm_g)
    k_rope = apply_rope(ckv[..., KV_LORA:], cos, sin)
    k_nope = (latent @ w_uk).reshape(b, s_len, MLA_HEADS, MLA_NOPE)
    v = (latent @ w_uv).reshape(b, s_len, MLA_HEADS, MLA_V)
    return k_nope, k_rope, v


def mla_mixer(h, w_dq, q_norm_g, w_uq, w_out, k_nope, k_rope, v, cos, sin):
    b, s_len, _ = h.shape
    q = (rmsnorm(h @ w_dq, q_norm_g) @ w_uq).reshape(b, s_len, MLA_HEADS, MLA_NOPE + MLA_ROPE)
    q_nope = q[..., :MLA_NOPE]
    q_rope = apply_rope(q[..., MLA_NOPE:], cos[:, None, :], sin[:, None, :])
    kpos = jnp.arange(s_len)
    scale = (MLA_NOPE + MLA_ROPE) ** -0.5

    def block(args):
        i, qn, qr = args
        sc = (jnp.einsum('bqhd,bkhd->bhqk', qn, k_nope, preferred_element_type=jnp.float32)
              + jnp.einsum('bqhr,bkr->bhqk', qr, k_rope, preferred_element_type=jnp.float32)) * scale
        qpos = i * QBLOCK + jnp.arange(QBLOCK)
        visible = kpos[None, :] < (qpos[:, None] // CHUNK + 1) * CHUNK
        sc = jnp.where(visible, sc, -jnp.inf)
        p = jax.nn.softmax(sc, axis=-1).astype(v.dtype)
        return jnp.einsum('bhqk,bkhd->bqhd', p, v)

    o = lax.map(block, (jnp.arange(s_len // QBLOCK), to_blocks(q_nope), to_blocks(q_rope)))
    return from_blocks(o).reshape(b, s_len, MLA_HEADS * MLA_V) @ w_out


def conv_ffn(h, w_in, conv_w, conv_b, w_out):
    s_len = h.shape[1]
    u = h @ w_in
    up = jnp.pad(u, ((0, 0), (CONV_W - 1, 0), (0, 0)))
    u = conv_b + sum(up[:, j:j + s_len] * conv_w[j] for j in range(CONV_W))
    gate, val = jnp.split(u, 2, axis=-1)
    return (jax.nn.silu(gate) * val) @ w_out


def setup_inputs(seed: int = 0) -> dict:
    key = jax.random.key(seed)
    ks = jax.random.split(key, 24)
    f32 = jnp.float32
    res = (2.0 * DEPTH) ** -0.5

    def nrm(k, shape, scale):
        return jax.random.normal(k, shape, f32) * scale

    def gain(k, shape):
        return 1.0 + 0.02 * jax.random.normal(k, shape, f32)

    w_fox_in = jnp.concatenate([
        nrm(ks[2], (N_A, D_MODEL, 3 * FOX_WIDTH), D_MODEL ** -0.5),
        nrm(ks[3], (N_A, D_MODEL, FOX_HEADS), 0.1 * D_MODEL ** -0.5)], axis=-1)
    return {
        'x': jax.random.normal(ks[0], (BATCH, SEQ, D_MODEL), f32),
        'fox_norm': gain(ks[1], (N_A, D_MODEL)),
        'w_fox_in': w_fox_in,
        'b_fox_f': jax.random.uniform(ks[4], (N_A, FOX_HEADS), f32, 1.0, 6.0),
        'w_fox_out': nrm(ks[5], (N_A, FOX_WIDTH, D_MODEL), FOX_WIDTH ** -0.5 * res),
        'kv_in_norm': gain(ks[6], (D_MODEL,)),
        'w_dkv': nrm(ks[7], (D_MODEL, KV_LORA + MLA_ROPE), D_MODEL ** -0.5),
        'kv_norm': gain(ks[8], (KV_LORA,)),
        'w_uk': nrm(ks[9], (KV_LORA, MLA_HEADS * MLA_NOPE), KV_LORA ** -0.5),
        'w_uv': nrm(ks[10], (KV_LORA, MLA_HEADS * MLA_V), KV_LORA ** -0.5),
        'mla_norm': gain(ks[11], (N_B, D_MODEL)),
        'w_dq': nrm(ks[12], (N_B, D_MODEL, Q_LORA), D_MODEL ** -0.5),
        'q_norm': gain(ks[13], (N_B, Q_LORA)),
        'w_uq': nrm(ks[14], (N_B, Q_LORA, MLA_HEADS * (MLA_NOPE + MLA_ROPE)), Q_LORA ** -0.5),
        'w_mla_out': nrm(ks[15], (N_B, MLA_HEADS * MLA_V, D_MODEL), (MLA_HEADS * MLA_V) ** -0.5 * res),
        'ffn_norm': gain(ks[16], (DEPTH, D_MODEL)),
        'w_ffn_in': nrm(ks[17], (DEPTH, D_MODEL, 2 * D_FF), D_MODEL ** -0.5),
        'ffn_conv_w': nrm(ks[18], (DEPTH, CONV_W, 2 * D_FF), CONV_W ** -0.5),
        'ffn_conv_b': nrm(ks[19], (DEPTH, 2 * D_FF), 0.01),
        'w_ffn_out': nrm(ks[20], (DEPTH, D_FF, D_MODEL), D_FF ** -0.5 * res),
        'final_norm': gain(ks[21], (D_MODEL,)),
    }


def reference(x, fox_norm, w_fox_in, b_fox_f, w_fox_out, kv_in_norm, w_dkv, kv_norm, w_uk, w_uv,
              mla_norm, w_dq, q_norm, w_uq, w_mla_out, ffn_norm, w_ffn_in, ffn_conv_w, ffn_conv_b,
              w_ffn_out, final_norm):
    cos, sin = rope_tables(x.shape[1], x.dtype)
    k_nope = k_rope = v = None
    for layer in range(DEPTH):
        if layer < N_A:
            x = x + fox_mixer(rmsnorm(x, fox_norm[layer]), w_fox_in[layer], b_fox_f[layer],
                              w_fox_out[layer])
        else:
            if layer == N_A:
                k_nope, k_rope, v = mla_shared_kv(x, kv_in_norm, w_dkv, kv_norm, w_uk, w_uv, cos, sin)
            j = layer - N_A
            x = x + mla_mixer(rmsnorm(x, mla_norm[j]), w_dq[j], q_norm[j], w_uq[j], w_mla_out[j],
                              k_nope, k_rope, v, cos, sin)
        x = x + conv_ffn(rmsnorm(x, ffn_norm[layer]), w_ffn_in[layer], ffn_conv_w[layer],
                         ffn_conv_b[layer], w_ffn_out[layer])
    return rmsnorm(x, final_norm)
```

```cpp
#include <hip/hip_runtime.h>
#include <hip/hip_cooperative_groups.h>
#include <cstdio>
#include <cstdint>
namespace cg = cooperative_groups;
#ifndef ATT_SGB
#define ATT_SGB 1
#endif
#ifndef MK_PROBE
#define MK_PROBE 0
#endif
namespace pg8 {
#define PG8_LAS __attribute__((address_space(3)))
typedef unsigned short bf16_t;
typedef short bf16x8 __attribute__((ext_vector_type(8)));
typedef float f32x4 __attribute__((ext_vector_type(4)));
typedef unsigned u32x4 __attribute__((ext_vector_type(4)));
constexpr int BM = 256, BK = 64, HALF = 128, HTB = HALF * BK * 2  , STAGE_BYTES = 8 * HTB, NXCD = 8, WGM = 8;

__host__ __device__ __forceinline__ int lds_byte(int r, int c) { const int st = (r >> 4) * 2 + (c >> 5), rr = r & 15, cc = c & 31, ob = rr * 64 + cc * 2; return st * 1024 + (ob ^ (((ob >> 9) & 1) << 5)); }
__host__ __device__ __forceinline__ void stage_rc(int b, int& R, int& C) { const int st = b / 1024, sb = b % 1024, swz = sb ^ (((sb >> 9) & 1) << 5); R = (st >> 1) * 16 + swz / 64; C = (st & 1) * 32 + (swz % 64) / 2; }
__host__ __device__ __forceinline__ int perm32(int rho) { const int n = rho >> 4, i = rho & 15; return 8 * (i >> 2) + 4 * n + (i & 3); }

struct Unit { int pm, pn, ar; };
struct Gemm { const bf16_t* A; const bf16_t* Bt; int M, N, K, lda; };

struct StaticOrder {
    int nM, nN, nwg, G, c;
    __host__ __device__ void init(int M, int N, int G_, int c_) { nM = M / BM; nN = N / BM; nwg = nM * nN; G = G_; c = c_; }
    __host__ __device__ bool next(int i, Unit& u) const {
        const long L = (long)i * G + c; if (L >= nwg) return false;
        int wgid = (int)L; { const int q = nwg / NXCD, r = nwg % NXCD, xcd = wgid % NXCD, off = wgid / NXCD; wgid = (xcd < r ? xcd * (q + 1) : r * (q + 1) + (xcd - r) * q) + off; }
        const int nig = WGM * nN, gid = wgid / nig, fm = gid * WGM, gsz = (nM - fm) < WGM ? (nM - fm) : WGM;
        u.pm = fm + ((wgid % nig) % gsz); u.pn = (wgid % nig) / gsz; u.ar = u.pm * BM; return true;
    }
    __device__ __forceinline__ void a_ready(const Unit&) const {}
    __device__ __forceinline__ void done(const Unit&) const {}
};

template <class Epi, class Sched, bool ALIGN_EPI = false, bool SP2 = false, int AMAP = 0>
__device__ __forceinline__ void gemm_phase(PG8_LAS unsigned char* lds, const Gemm g, const Sched& S, const Epi& E) {
    const int tid = threadIdx.x, wid = __builtin_amdgcn_readfirstlane(tid >> 6), lane = tid & 63, wr = wid >> 2, wc = wid & 3, fr = lane & 15, fq = lane >> 4;
    const int K = g.K, nt = K / BK;
    unsigned voffA[2], voffB[2];
#pragma unroll
    for (int i = 0; i < 2; ++i) { int R, C; stage_rc(tid * 16 + i * 8192, R, C); const int Rb = Epi::PERM ? ((R & ~31) + perm32(R & 31)) : R;
        voffA[i] = (unsigned)(R * g.lda + C) * 2u; voffB[i] = (unsigned)(Rb * K + C) * 2u; }
    const size_t kstep = (size_t)(BK * 2);
    const size_t hstepB = (size_t)HALF * K * 2, hstepA = (size_t)HALF * g.lda * 2;
    const size_t tstep = 2 * hstepB;
    const unsigned ldsw = (unsigned)wid * 1024u;
    const int aoff = lds_byte(wr * 64 + fr, fq * 8), boff = lds_byte(wc * 32 + fr, fq * 8);
#define PG8_AK(t) ((size_t)(AMAP == 1 ? ((((t) >> 1) * 192 + ((t) & 1) * 64) * 2) : ((t) * (BK * 2))))
#define PG8_SA(b, h) (((b) * 2 + (h)) * HTB)
#define PG8_SB(b, h) ((4 + (b) * 2 + (h)) * HTB)
#define PG8_STAGE(bufoff, gbase, voff) do { _Pragma("unroll") for (int _i = 0; _i < 2; ++_i) \
        __builtin_amdgcn_global_load_lds((const unsigned*)((const char*)(gbase) + (voff)[_i]), (PG8_LAS unsigned*)(lds + (bufoff) + ldsw + _i * 8192), 16, 0, 0); } while (0)
#define PG8_LDA(dst, b, h) do { _Pragma("unroll") for (int m = 0; m < 4; ++m) _Pragma("unroll") for (int k = 0; k < 2; ++k) dst[m][k] = *(const PG8_LAS bf16x8*)(lds + PG8_SA(b, h) + aoff + m * 2048 + k * 1024); } while (0)
#define PG8_LDB(dst, b, h) do { _Pragma("unroll") for (int n = 0; n < 2; ++n) _Pragma("unroll") for (int k = 0; k < 2; ++k) dst[n][k] = *(const PG8_LAS bf16x8*)(lds + PG8_SB(b, h) + boff + n * 2048 + k * 1024); } while (0)
#define PG8_MMA(ai, bj, At, Bt) do { __builtin_amdgcn_s_setprio(1); _Pragma("unroll") for (int m = 0; m < 4; ++m) _Pragma("unroll") for (int n = 0; n < 2; ++n) _Pragma("unroll") for (int k = 0; k < 2; ++k) \
        acc[ai][bj][m][n] = __builtin_amdgcn_mfma_f32_16x16x32_bf16(Bt[n][k], At[m][k], acc[ai][bj][m][n], 0, 0, 0); __builtin_amdgcn_s_setprio(0); } while (0)
#define PG8_WAIT_V(n) asm volatile("s_waitcnt vmcnt(" #n ")" ::: "memory")
#define PG8_WAIT_L(n) asm volatile("s_waitcnt lgkmcnt(" #n ")" ::: "memory")
#define PG8_BAR __builtin_amdgcn_s_barrier()
#define PG8_SCHED __builtin_amdgcn_sched_barrier(0)
    Unit cur, nxt; int ui = 0;
    if (!S.next(0, cur)) return;
    f32x4 acc[2][2][4][2];
#pragma unroll
    for (int a = 0; a < 2; ++a)
#pragma unroll
        for (int b = 0; b < 2; ++b)
#pragma unroll
            for (int m = 0; m < 4; ++m)
#pragma unroll
                for (int n = 0; n < 2; ++n) acc[a][b][m][n] = (f32x4){0.f, 0.f, 0.f, 0.f};
    bf16x8 At[4][2], B0[2][2], B1[2][2];
    const char* cA = (const char*)g.A + (long)cur.ar * (long)g.lda * 2; const char* cB = (const char*)g.Bt + (size_t)cur.pn * tstep;
    S.a_ready(cur);
    if constexpr (SP2) {
        PG8_STAGE(PG8_SB(0, 0), cB, voffB); PG8_STAGE(PG8_SB(0, 1), cB + hstepB, voffB); PG8_STAGE(PG8_SA(0, 0), cA, voffA); PG8_STAGE(PG8_SA(0, 1), cA + hstepA, voffA);
        if (wr == 1) PG8_BAR;
        PG8_WAIT_V(2); PG8_BAR;
        PG8_STAGE(PG8_SB(1, 0), cB + kstep, voffB); PG8_STAGE(PG8_SA(1, 0), cA + PG8_AK(1), voffA); PG8_STAGE(PG8_SB(1, 1), cB + hstepB + kstep, voffB);
        PG8_WAIT_V(6); PG8_BAR;
    } else {
        PG8_STAGE(PG8_SB(0, 0), cB, voffB); PG8_STAGE(PG8_SA(0, 0), cA, voffA); PG8_STAGE(PG8_SB(0, 1), cB + hstepB, voffB); PG8_STAGE(PG8_SA(0, 1), cA + hstepA, voffA);
        if (wr == 1) PG8_BAR;
        PG8_WAIT_V(4); PG8_BAR;
        PG8_STAGE(PG8_SB(1, 0), cB + kstep, voffB); PG8_STAGE(PG8_SA(1, 0), cA + PG8_AK(1), voffA); PG8_STAGE(PG8_SB(1, 1), cB + hstepB + kstep, voffB);
        PG8_WAIT_V(6); PG8_BAR;
    }
    for (;;) {
        const bool has_next = S.next(ui + 1, nxt);
        const char* nA = has_next ? (const char*)g.A + (long)nxt.ar * (long)g.lda * 2 : cA; const char* nB = has_next ? (const char*)g.Bt + (size_t)nxt.pn * tstep : cB;
        for (int t = 0; t < nt; t += 2) {
            const bool last = (t == nt - 2);
            const char* a1 = cA + PG8_AK(t + 1);
            const char* a2 = last ? nA : cA + PG8_AK(t + 2); const char* b2 = last ? nB : cB + (size_t)(t + 2) * kstep;
            const char* a3 = last ? nA + PG8_AK(1) : cA + PG8_AK(t + 3); const char* b3 = b2 + kstep;
            if (last && has_next) S.a_ready(nxt);
            if constexpr (SP2) {
            PG8_LDB(B0, 0, 0); PG8_LDB(B1, 0, 1); PG8_SCHED; PG8_LDA(At, 0, 0); PG8_STAGE(PG8_SA(1, 1), a1 + hstepA, voffA);
            PG8_WAIT_V(8); PG8_WAIT_L(0); PG8_BAR; PG8_MMA(0, 0, At, B0); PG8_MMA(0, 1, At, B1); PG8_BAR; PG8_SCHED;
            PG8_LDA(At, 0, 1); PG8_STAGE(PG8_SB(0, 0), b2, voffB); PG8_STAGE(PG8_SB(0, 1), b2 + hstepB, voffB); PG8_STAGE(PG8_SA(0, 0), a2, voffA);
            PG8_WAIT_V(8); PG8_WAIT_L(0); PG8_BAR; PG8_MMA(1, 0, At, B0); PG8_MMA(1, 1, At, B1); PG8_BAR; PG8_SCHED;
            PG8_LDB(B0, 1, 0); PG8_LDB(B1, 1, 1); PG8_SCHED; PG8_LDA(At, 1, 0); PG8_STAGE(PG8_SA(0, 1), a2 + hstepA, voffA);
            PG8_WAIT_V(8); PG8_WAIT_L(0); PG8_BAR; PG8_MMA(0, 0, At, B0); PG8_MMA(0, 1, At, B1); PG8_BAR; PG8_SCHED;
            PG8_LDA(At, 1, 1); PG8_STAGE(PG8_SB(1, 0), b3, voffB); PG8_STAGE(PG8_SB(1, 1), b3 + hstepB, voffB); PG8_STAGE(PG8_SA(1, 0), a3, voffA);
            PG8_WAIT_V(8); PG8_WAIT_L(0); PG8_BAR; PG8_MMA(1, 0, At, B0); PG8_MMA(1, 1, At, B1); PG8_BAR; PG8_SCHED;
            } else {
            PG8_LDB(B0, 0, 0); PG8_SCHED; PG8_LDA(At, 0, 0); PG8_STAGE(PG8_SA(1, 1), a1 + hstepA, voffA);
            PG8_WAIT_L(8); PG8_BAR; PG8_WAIT_L(0); PG8_MMA(0, 0, At, B0); PG8_BAR; PG8_SCHED;
            PG8_LDB(B1, 0, 1); PG8_STAGE(PG8_SB(0, 0), b2, voffB);
            PG8_BAR; PG8_WAIT_L(0); PG8_MMA(0, 1, At, B1); PG8_BAR;
            PG8_LDA(At, 0, 1); PG8_STAGE(PG8_SA(0, 0), a2, voffA);
            PG8_BAR; PG8_WAIT_L(0); PG8_MMA(1, 0, At, B0); PG8_BAR; PG8_SCHED;
            PG8_STAGE(PG8_SB(0, 1), b2 + hstepB, voffB);
            PG8_WAIT_V(6); PG8_BAR; PG8_MMA(1, 1, At, B1); PG8_BAR;
            PG8_LDB(B0, 1, 0); PG8_SCHED; PG8_LDA(At, 1, 0); PG8_STAGE(PG8_SA(0, 1), a2 + hstepA, voffA);
            PG8_WAIT_L(8); PG8_BAR; PG8_WAIT_L(0); PG8_MMA(0, 0, At, B0); PG8_BAR; PG8_SCHED;
            PG8_LDB(B1, 1, 1); PG8_STAGE(PG8_SB(1, 0), b3, voffB);
            PG8_BAR; PG8_WAIT_L(0); PG8_MMA(0, 1, At, B1); PG8_BAR;
            PG8_LDA(At, 1, 1); PG8_STAGE(PG8_SA(1, 0), a3, voffA);
            PG8_BAR; PG8_WAIT_L(0); PG8_MMA(1, 0, At, B0); PG8_BAR; PG8_SCHED;
            PG8_STAGE(PG8_SB(1, 1), b3 + hstepB, voffB);
            PG8_WAIT_V(6); PG8_BAR; PG8_MMA(1, 1, At, B1); PG8_BAR;
            }
        }
        if constexpr (ALIGN_EPI) { if (wr == 0) PG8_BAR; }
        if constexpr (!Epi::AFTER_DRAIN) { E(acc, cur, wr, wc, fr, fq); S.done(cur); }
        if (!has_next) break;
#pragma unroll
        for (int a = 0; a < 2; ++a)
#pragma unroll
            for (int b = 0; b < 2; ++b)
#pragma unroll
                for (int m = 0; m < 4; ++m)
#pragma unroll
                    for (int n = 0; n < 2; ++n) acc[a][b][m][n] = (f32x4){0.f, 0.f, 0.f, 0.f};
        cur = nxt; cA = nA; cB = nB; ++ui;
        if constexpr (ALIGN_EPI) { if (wr == 1) PG8_BAR; }
    }
    PG8_WAIT_V(0);
    if constexpr (!ALIGN_EPI) { if (wr == 0) PG8_BAR; }
    PG8_BAR;
    if constexpr (Epi::AFTER_DRAIN) { E.fused(acc, cur, wr, wc, fr, fq, lds, wid, lane); S.done(cur); }
#undef PG8_AK
#undef PG8_SA
#undef PG8_SB
#undef PG8_STAGE
#undef PG8_LDA
#undef PG8_LDB
#undef PG8_MMA
#undef PG8_WAIT_V
#undef PG8_WAIT_L
#undef PG8_BAR
#undef PG8_SCHED
}
}

#define LAS __attribute__((address_space(3)))
typedef unsigned short bf16_t;
typedef short bf16x8 __attribute__((ext_vector_type(8)));
typedef short s16x4 __attribute__((ext_vector_type(4)));
typedef float f32x4 __attribute__((ext_vector_type(4)));
typedef float f32x2 __attribute__((ext_vector_type(2)));
typedef float f32x16 __attribute__((ext_vector_type(16)));
typedef unsigned u32x4 __attribute__((ext_vector_type(4)));
typedef unsigned u32x2 __attribute__((ext_vector_type(2)));

constexpr int BATCH = 4, SEQ = 8192, DM = 1024, M = BATCH * SEQ;
constexpr int DFF = 2816, NFF2 = 2 * DFF;
constexpr float EPS = 1e-6f;
constexpr float L2E = 1.4426950408889634f;
constexpr float C2F = 0.125f * L2E;
constexpr float C2M = 0.07216878364870322f * L2E;
constexpr size_t MiB = 1u << 20;
constexpr size_t WS_CTOT = 64 * 1024;
constexpr size_t WS_RSTD0 = 1 * MiB;
constexpr size_t WS_SSQ1 = WS_RSTD0 + 128 * 1024, WS_SSQ2 = WS_SSQ1 + 128 * 1024, WS_SSQ3 = WS_SSQ2 + 128 * 1024, WS_SSQQ = WS_SSQ3 + 128 * 1024, WS_SSQL = WS_SSQQ + 128 * 1024;
constexpr size_t WS_LOGF = 2 * MiB, WS_CUMT = 4 * MiB, WS_ROPE = 6 * MiB;
constexpr size_t WS_WQKV = 8 * MiB, WS_WFO = 14 * MiB, WS_WFI0 = 16 * MiB, WS_WFD0 = 27 * MiB;
constexpr size_t WS_LAT = 8 * MiB, WS_KR = 24 * MiB;
constexpr size_t WS_WFI1 = 33 * MiB, WS_WFD1 = 44 * MiB, WS_WDN = 50 * MiB, WS_WUQ = 53 * MiB, WS_WUKV = 58 * MiB, WS_WMO = 60 * MiB;
constexpr size_t WS_QM = 64 * MiB, WS_KN = 256 * MiB, WS_VM = 384 * MiB;
constexpr size_t WS_XB = 386 * MiB;
constexpr size_t WS_CQ = 256 * MiB;
constexpr size_t WS_Q0 = 64 * MiB, WS_K0 = 128 * MiB, WS_V0 = 192 * MiB;
constexpr size_t WS_G = 64 * MiB;
constexpr size_t WS_END = 512 * MiB;
constexpr int LDS_XCH = 131072, LDS_MISC = 131072 + 8192, LDS_BYTES = 147456;

__device__ __forceinline__ unsigned cvtpk(float lo, float hi) { typedef __bf16 bf2 __attribute__((ext_vector_type(2))); f32x2 v = {lo, hi}; bf2 b = __builtin_convertvector(v, bf2); return __builtin_bit_cast(unsigned, b); }
__device__ __forceinline__ float wave_sum(float v) {
#pragma unroll
    for (int o = 1; o < 64; o <<= 1) v += __shfl_xor(v, o);
    return v;
}
__device__ __forceinline__ void atomic_addf(float* p, float v) { (void)__hip_atomic_fetch_add(p, v, __ATOMIC_RELAXED, __HIP_MEMORY_SCOPE_AGENT); }
__device__ __forceinline__ int ropedim(int p) { return 4 * (p >> 3) + (p & 3) + 32 * ((p >> 2) & 1); }

__device__ __forceinline__ int srccol(int mode, int c0, int n) {
    if (mode == 0) return c0 + n;
    if (mode == 1) return ((n & 128) ? DFF : 0) + (n >> 8) * 128 + (n & 127);
    if (mode == 2) return c0 + ropedim(n);
    if (n < 2048) return (n >> 7) * 192 + (n & 127);
    const int m = n - 2048; return (m >> 6) * 192 + 128 + ropedim(m & 63);
}
__device__ __forceinline__ void tr_item(const float* __restrict__ W, int K, int N, bf16_t* WT, int row_off, const float* __restrict__ gain, int mode, int c0, int nblk, LAS float* scr, int item, int lane) {
    const int kb = item / nblk, nb = item % nblk, k0 = 64 * kb, n0 = 32 * nb;
    const int col = srccol(mode, c0, n0 + (lane & 31));
    float vals[32], gv[32];
#pragma unroll
    for (int i = 0; i < 32; ++i) { const int kk = 2 * i + (lane >> 5); vals[i] = W[(size_t)(k0 + kk) * N + col]; gv[i] = gain ? gain[k0 + kk] : 1.0f; }
#pragma unroll
    for (int i = 0; i < 32; ++i) { const int kk = 2 * i + (lane >> 5); scr[kk * 33 + (lane & 31)] = vals[i] * gv[i]; }
    asm volatile("s_waitcnt lgkmcnt(0)" ::: "memory");
    const int c = lane & 7;
#pragma unroll
    for (int j = 0; j < 4; ++j) { const int n = (lane >> 3) + 8 * j; const LAS float* s = scr + (8 * c) * 33 + n;
        u32x4 o; o.x = cvtpk(s[0 * 33], s[1 * 33]); o.y = cvtpk(s[2 * 33], s[3 * 33]); o.z = cvtpk(s[4 * 33], s[5 * 33]); o.w = cvtpk(s[6 * 33], s[7 * 33]);
        *(u32x4*)(WT + (size_t)(row_off + n0 + n) * K + k0 + 8 * c) = o; }
    asm volatile("s_waitcnt lgkmcnt(0)" ::: "memory");
}

struct P { const float *x, *fox_norm, *w_fox_in, *b_fox_f, *w_fox_out, *kv_in_norm, *w_dkv, *kv_norm, *w_uk, *w_uv, *mla_norm, *w_dq, *q_norm, *w_uq, *w_mla_out, *ffn_norm, *w_ffn_in, *ffn_conv_w, *ffn_conv_b, *w_ffn_out, *final_norm; float* out; unsigned char* ws; };

__device__ __forceinline__ void phase_prologue(const P& p, LAS unsigned char* lds, int gw, int NGW, int gtid, int NGT, int part) {
    const int tid = threadIdx.x, lane = tid & 63, wave = tid >> 6;
    unsigned char* ws = p.ws;
    LAS float* scr = (LAS float*)(lds + wave * 8704);
#define TRJOB(cnt, W, K, N, WT, roff, gain, mode, c0, nrows) { const int n_ = (K / 64) * ((nrows) / 32); if (r < n_) { tr_item(W, K, N, (bf16_t*)(ws + (WT)), roff, gain, mode, c0, (nrows) / 32, scr, r, lane); continue; } r -= n_; }
    if (part & 1) {
    constexpr int NITEMS = 16 * 96 + 16 * 32 + 2 * 16 * 176 + 2 * 44 * 32 + 16 * 24 + 16 * 8 + 16 * 2 + 12 * 96 + 4 * 64 * 2 + 32 * 32;
    for (int it = gw; it < NITEMS; it += NGW) {
        int r = it;
        TRJOB(0, p.w_fox_in, 1024, 3088, WS_WQKV, 0, p.fox_norm, 0, 0, 3072)
        TRJOB(0, p.w_fox_out, 1024, 1024, WS_WFO, 0, (const float*)nullptr, 0, 0, 1024)
        TRJOB(0, p.w_ffn_in, 1024, NFF2, WS_WFI0, 0, p.ffn_norm, 1, 0, NFF2)
        TRJOB(0, p.w_ffn_in + (size_t)1024 * NFF2, 1024, NFF2, WS_WFI1, 0, p.ffn_norm + 1024, 1, 0, NFF2)
        TRJOB(0, p.w_ffn_out, DFF, 1024, WS_WFD0, 0, (const float*)nullptr, 0, 0, 1024)
        TRJOB(0, p.w_ffn_out + (size_t)DFF * 1024, DFF, 1024, WS_WFD1, 0, (const float*)nullptr, 0, 0, 1024)
        TRJOB(0, p.w_dq, 1024, 768, WS_WDN, 0, p.mla_norm, 0, 0, 768)
        TRJOB(0, p.w_dkv, 1024, 320, WS_WDN, 768, p.kv_in_norm, 0, 0, 256)
        TRJOB(0, p.w_dkv, 1024, 320, WS_WDN, 1024, p.kv_in_norm, 2, 256, 64)
        TRJOB(0, p.w_uq, 768, 3072, WS_WUQ, 0, p.q_norm, 3, 0, 3072)
        TRJOB(0, p.w_uk, 256, 2048, WS_WUKV, 0, p.kv_norm, 0, 0, 2048)
        TRJOB(0, p.w_uv, 256, 2048, WS_WUKV, 2048, p.kv_norm, 0, 0, 2048)
        TRJOB(0, p.w_mla_out, 2048, 1024, WS_WMO, 0, (const float*)nullptr, 0, 0, 1024)
    }
#undef TRJOB
    { float* z = (float*)(ws + WS_SSQ1); for (int i = gtid; i < 5 * M; i += NGT) z[i] = 0.f; }
    { f32x2* rt = (f32x2*)(ws + WS_ROPE);
      for (int i = gtid; i < SEQ * 32; i += NGT) { const int pos = i >> 5, f = i & 31;
          const float inv = (float)exp2(-(double)f * (13.287712379549449 / 32.0));
          const float ang = (float)pos * inv;
          const double a = (double)ang; const double k = rint(a * 0.6366197723675814);
          double r = fma(-k, 1.5707963267948966, a); r = fma(-k, 6.123233995736766e-17, r);
          const double r2 = r * r;
          double sn = r2 * (1.0 / 6227020800.0) - (1.0 / 39916800.0); sn = sn * r2 + (1.0 / 362880.0); sn = sn * r2 - (1.0 / 5040.0); sn = sn * r2 + (1.0 / 120.0); sn = sn * r2 - (1.0 / 6.0); sn = sn * r2 * r + r;
          double cs = r2 * (-1.0 / 87178291200.0) + (1.0 / 479001600.0); cs = cs * r2 - (1.0 / 3628800.0); cs = cs * r2 + (1.0 / 40320.0); cs = cs * r2 - (1.0 / 720.0); cs = cs * r2 + (1.0 / 24.0); cs = cs * r2 - 0.5; cs = cs * r2 + 1.0;
          const int q = ((int)k) & 3; const double c = (q == 0) ? cs : (q == 1) ? -sn : (q == 2) ? -cs : sn; const double s = (q == 0) ? sn : (q == 1) ? cs : (q == 2) ? -sn : -cs;
          rt[i] = (f32x2){(float)c, (float)s}; } }
    }
    if (!(part & 2)) return;
    __syncthreads();
    LAS float* wft = (LAS float*)lds;
    { float wv[32], gv2[32];
#pragma unroll
      for (int it = 0; it < 32; ++it) { const int i = tid + 512 * it, k = i >> 4, h = i & 15; wv[it] = p.w_fox_in[(size_t)k * 3088 + 3072 + h]; gv2[it] = p.fox_norm[k]; }
#pragma unroll
      for (int it = 0; it < 32; ++it) { const int i = tid + 512 * it, k = i >> 4, h = i & 15; wft[h * 1024 + k] = wv[it] * gv2[it]; } }
    __syncthreads();
    { bf16_t* XB = (bf16_t*)(ws + WS_XB); float* rstd0 = (float*)(ws + WS_RSTD0); float* logf_ = (float*)(ws + WS_LOGF);
      const float bfh = p.b_fox_f[(lane >> 2) & 15];
      f32x4 v[4];
      if (gw < M) { const f32x4* xr0 = (const f32x4*)(p.x + (size_t)gw * DM) + lane;
#pragma unroll
          for (int j = 0; j < 4; ++j) v[j] = xr0[64 * j]; }
      for (int m = gw; m < M; m += NGW) {
          asm volatile("" ::: "memory");
          f32x4 nv[4];
          { const int mn = (m + NGW < M) ? m + NGW : m; const f32x4* xrn = (const f32x4*)(p.x + (size_t)mn * DM) + lane;
#pragma unroll
            for (int j = 0; j < 4; ++j) nv[j] = xrn[64 * j]; }
          float s = 0.f;
#pragma unroll
          for (int j = 0; j < 4; ++j) s += (v[j].x * v[j].x + v[j].y * v[j].y) + (v[j].z * v[j].z + v[j].w * v[j].w);
          const float rstd = 1.0f / sqrtf(wave_sum(s) * (1.0f / DM) + EPS);
          unsigned long long* o8 = (unsigned long long*)(XB + (size_t)m * DM) + lane;
#pragma unroll
          for (int j = 0; j < 4; ++j) o8[64 * j] = (unsigned long long)cvtpk(v[j].x, v[j].y) | ((unsigned long long)cvtpk(v[j].z, v[j].w) << 32);
          float a[16];
#pragma unroll
          for (int h = 0; h < 16; ++h) { float t = 0.f;
#pragma unroll
              for (int j = 0; j < 4; ++j) { const f32x4 w = *(const LAS f32x4*)(wft + h * 1024 + 256 * j + 4 * lane); t += (v[j].x * w.x + v[j].y * w.y) + (v[j].z * w.z + v[j].w * w.w); }
              a[h] = t; }
#pragma unroll
          for (int k = 0; k < 8; ++k) { const float keep = (lane & 32) ? a[k + 8] : a[k], send = (lane & 32) ? a[k] : a[k + 8]; a[k] = keep + __shfl_xor(send, 32); }
#pragma unroll
          for (int k = 0; k < 4; ++k) { const float keep = (lane & 16) ? a[k + 4] : a[k], send = (lane & 16) ? a[k] : a[k + 4]; a[k] = keep + __shfl_xor(send, 16); }
#pragma unroll
          for (int k = 0; k < 2; ++k) { const float keep = (lane & 8) ? a[k + 2] : a[k], send = (lane & 8) ? a[k] : a[k + 2]; a[k] = keep + __shfl_xor(send, 8); }
          { const float keep = (lane & 4) ? a[1] : a[0], send = (lane & 4) ? a[0] : a[1]; a[0] = keep + __shfl_xor(send, 4); }
          a[0] += __shfl_xor(a[0], 2); a[0] += __shfl_xor(a[0], 1);
          const float z = a[0] * rstd + bfh;
          const float ls = fminf(z, 0.f) - log1pf(__expf(-fabsf(z)));
          if (lane == 0) rstd0[m] = rstd;
          if ((lane & 3) == 0) logf_[(size_t)m * 16 + (lane >> 2)] = ls;
#pragma unroll
          for (int j = 0; j < 4; ++j) v[j] = nv[j];
      } }
}

__device__ __forceinline__ void chunk_scan(const P& p, LAS unsigned char* lds, int c) {
    const int tid = threadIdx.x, h = tid & 15, seg = tid >> 4;
    const float* lf = (const float*)(p.ws + WS_LOGF) + ((size_t)c * 256 + seg * 8) * 16 + h;
    float s[8]; float run = 0.f;
#pragma unroll
    for (int i = 0; i < 8; ++i) { run += lf[i * 16]; s[i] = run; }
    LAS float* tot = (LAS float*)(lds + LDS_MISC);
    tot[seg * 16 + h] = run;
    __syncthreads();
    float off = 0.f;
    for (int g = 0; g < seg; ++g) off += tot[g * 16 + h];
    const int b = c >> 5, cc = c & 31;
    float* ct = (float*)(p.ws + WS_CUMT) + ((size_t)(b * 16 + h)) * SEQ + cc * 256 + seg * 8;
#pragma unroll
    for (int i = 0; i < 8; ++i) ct[i] = (off + s[i]) * L2E;
    if (seg == 31) ((float*)(p.ws + WS_CTOT))[c * 16 + h] = (off + run) * L2E;
    __syncthreads();
}

__device__ __forceinline__ void phase_final(const P& p, int gw, int NGW) {
    const int lane = threadIdx.x & 63;
    f32x4 g[4];
#pragma unroll
    for (int j = 0; j < 4; ++j) g[j] = ((const f32x4*)p.final_norm)[64 * j + lane];
    f32x4 v[4];
    if (gw < M) { const f32x4* x0 = (const f32x4*)(p.out + (size_t)gw * DM) + lane;
#pragma unroll
        for (int j = 0; j < 4; ++j) v[j] = x0[64 * j]; }
    for (int m = gw; m < M; m += NGW) {
        f32x4* xr = (f32x4*)(p.out + (size_t)m * DM) + lane;
        f32x4 nv[4];
        { const int mn = (m + NGW < M) ? m + NGW : m; const f32x4* xn = (const f32x4*)(p.out + (size_t)mn * DM) + lane;
#pragma unroll
          for (int j = 0; j < 4; ++j) nv[j] = xn[64 * j]; }
        float s = 0.f;
#pragma unroll
        for (int j = 0; j < 4; ++j) s += (v[j].x * v[j].x + v[j].y * v[j].y) + (v[j].z * v[j].z + v[j].w * v[j].w);
        const float rstd = 1.0f / sqrtf(wave_sum(s) * (1.0f / DM) + EPS);
#pragma unroll
        for (int j = 0; j < 4; ++j) xr[64 * j] = v[j] * rstd * g[j];
#pragma unroll
        for (int j = 0; j < 4; ++j) v[j] = nv[j];
    }
}

namespace epi {
using pg8::Unit; using pg8::BM; using pg8::HALF;

struct RowScaleSplit {
    static constexpr bool PERM = true, AFTER_DRAIN = false;
    bf16_t* O; int ldc; int split_cols; size_t split_stride; float scale0; const float* rsrc; float invn; int direct;
    __device__ __forceinline__ void operator()(const f32x4 (&acc)[2][2][4][2], const Unit& u, int wr, int wc, int fr, int fq) const {
        const int row0 = u.pm * BM + wr * 64 + fr; int colt = u.pn * BM; bf16_t* base = O;
        const int t = colt / split_cols; base += (size_t)t * split_stride; colt -= t * split_cols; const float sc = (t == 0) ? scale0 : 1.f;
        const int col0 = colt + wc * 32 + 8 * fq;
        float rsv[2][4];
#pragma unroll
        for (int ai = 0; ai < 2; ++ai)
#pragma unroll
            for (int m = 0; m < 4; ++m) rsv[ai][m] = rsrc[row0 + ai * HALF + m * 16];
#pragma unroll
        for (int ai = 0; ai < 2; ++ai)
#pragma unroll
            for (int m = 0; m < 4; ++m) { const int row = row0 + ai * HALF + m * 16; float rs = rsv[ai][m]; if (!direct) rs = 1.0f / sqrtf(rs * invn + EPS); rs *= sc;
                bf16_t* rowp = base + (size_t)row * ldc + col0;
#pragma unroll
                for (int bj = 0; bj < 2; ++bj) { const f32x4 v0 = acc[ai][bj][m][0] * rs, v1 = acc[ai][bj][m][1] * rs;
                    u32x4 w; w.x = cvtpk(v0[0], v0[1]); w.y = cvtpk(v0[2], v0[3]); w.z = cvtpk(v1[0], v1[1]); w.w = cvtpk(v1[2], v1[3]);
                    *(u32x4*)(rowp + bj * HALF) = w; } }
    }
};

struct Residual {
    static constexpr bool PERM = false, AFTER_DRAIN = false;
    const float* xold; float* out; bf16_t* xb; float* ssq;
    __device__ __forceinline__ void operator()(const f32x4 (&acc)[2][2][4][2], const Unit& u, int wr, int wc, int fr, int fq) const {
        const int col0 = u.pn * BM + wc * 32 + 4 * fq;
#pragma unroll
        for (int ai = 0; ai < 2; ++ai) {
            f32x4 xo[4][2][2];
#pragma unroll
            for (int m = 0; m < 4; ++m)
#pragma unroll
                for (int bj = 0; bj < 2; ++bj)
#pragma unroll
                    for (int n = 0; n < 2; ++n) xo[m][bj][n] = *(const f32x4*)(xold + (size_t)(u.pm * BM + ai * HALF + wr * 64 + m * 16 + fr) * DM + col0 + bj * HALF + n * 16);
#pragma unroll
            for (int m = 0; m < 4; ++m) { const int row = u.pm * BM + ai * HALF + wr * 64 + m * 16 + fr; const size_t off = (size_t)row * DM + col0; float ss = 0.f;
#pragma unroll
                for (int bj = 0; bj < 2; ++bj)
#pragma unroll
                    for (int n = 0; n < 2; ++n) { const size_t o = off + bj * HALF + n * 16; const f32x4 v = xo[m][bj][n] + acc[ai][bj][m][n];
                        *(f32x4*)(out + o) = v; ss += (v[0] * v[0] + v[1] * v[1]) + (v[2] * v[2] + v[3] * v[3]);
                        if (xb) { u32x2 w; w.x = cvtpk(v[0], v[1]); w.y = cvtpk(v[2], v[3]); *(u32x2*)(xb + o) = w; } }
                if (ssq) { ss += __shfl_xor(ss, 16); ss += __shfl_xor(ss, 32); if (fq == 0) atomic_addf(ssq + row, ss); } }
        }
    }
};

struct MlaDown {
    static constexpr bool PERM = true, AFTER_DRAIN = false;
    const float* ssq2; bf16_t* CQ; bf16_t* LAT; bf16_t* KR; float* ssqq; float* ssql; const f32x4* rope;
    __device__ __forceinline__ void operator()(const f32x4 (&acc)[2][2][4][2], const Unit& u, int wr, int wc, int fr, int fq) const {
        const int pn = u.pn;
        if (pn == 4 && wc >= 2) return;
        float rsv[2][4];
#pragma unroll
        for (int ai = 0; ai < 2; ++ai)
#pragma unroll
            for (int m = 0; m < 4; ++m) rsv[ai][m] = ssq2[u.pm * BM + ai * HALF + wr * 64 + m * 16 + fr];
#pragma unroll
        for (int ai = 0; ai < 2; ++ai) {
            f32x4 rpv[4][2];
            if (pn == 4) {
#pragma unroll
                for (int m = 0; m < 4; ++m) { const int row = u.pm * BM + ai * HALF + wr * 64 + m * 16 + fr; const int pos = row & (SEQ - 1); const f32x4* rp = rope + ((size_t)pos * 32 + 16 * wc + 4 * fq) / 2; rpv[m][0] = rp[0]; rpv[m][1] = rp[1]; } }
#pragma unroll
            for (int m = 0; m < 4; ++m) { const int row = u.pm * BM + ai * HALF + wr * 64 + m * 16 + fr; const float rs = 1.0f / sqrtf(rsv[ai][m] * (1.0f / DM) + EPS);
                if (pn < 4) { bf16_t* rowp = (pn < 3) ? CQ + (size_t)row * 768 + pn * 256 + wc * 32 + 8 * fq : LAT + (size_t)row * 256 + wc * 32 + 8 * fq; float ss = 0.f;
#pragma unroll
                    for (int bj = 0; bj < 2; ++bj) { const f32x4 v0 = acc[ai][bj][m][0] * rs, v1 = acc[ai][bj][m][1] * rs;
                        ss += (v0[0] * v0[0] + v0[1] * v0[1]) + (v0[2] * v0[2] + v0[3] * v0[3]) + (v1[0] * v1[0] + v1[1] * v1[1]) + (v1[2] * v1[2] + v1[3] * v1[3]);
                        u32x4 w; w.x = cvtpk(v0[0], v0[1]); w.y = cvtpk(v0[2], v0[3]); w.z = cvtpk(v1[0], v1[1]); w.w = cvtpk(v1[2], v1[3]);
                        *(u32x4*)(rowp + bj * HALF) = w; }
                    ss += __shfl_xor(ss, 16); ss += __shfl_xor(ss, 32); if (fq == 0) atomic_addf((pn < 3 ? ssqq : ssql) + row, ss);
                } else { const f32x4 cs0 = rpv[m][0], cs1 = rpv[m][1];
                    const f32x4 x1 = acc[ai][0][m][0] * rs, x2 = acc[ai][0][m][1] * rs;
                    const float c[4] = {cs0[0], cs0[2], cs1[0], cs1[2]}, s[4] = {cs0[1], cs0[3], cs1[1], cs1[3]};
                    float o1[4], o2[4];
#pragma unroll
                    for (int i = 0; i < 4; ++i) { o1[i] = x1[i] * c[i] - x2[i] * s[i]; o2[i] = x1[i] * s[i] + x2[i] * c[i]; }
                    u32x4 w; w.x = cvtpk(o1[0], o1[1]); w.y = cvtpk(o1[2], o1[3]); w.z = cvtpk(o2[0], o2[1]); w.w = cvtpk(o2[2], o2[3]);
                    *(u32x4*)(KR + (size_t)row * 64 + 32 * wc + 8 * fq) = w; } }
        }
    }
};

struct MlaUq {
    static constexpr bool PERM = true, AFTER_DRAIN = false;
    const float* ssqq; bf16_t* QM; const f32x4* rope;
    __device__ __forceinline__ void operator()(const f32x4 (&acc)[2][2][4][2], const Unit& u, int wr, int wc, int fr, int fq) const {
        const int pn = u.pn;
        float rsv[2][4];
#pragma unroll
        for (int ai = 0; ai < 2; ++ai)
#pragma unroll
            for (int m = 0; m < 4; ++m) rsv[ai][m] = ssqq[u.pm * BM + ai * HALF + wr * 64 + m * 16 + fr];
#pragma unroll
        for (int ai = 0; ai < 2; ++ai) {
            f32x4 rpv[4][2][2];
            if (pn >= 8) {
#pragma unroll
                for (int m = 0; m < 4; ++m)
#pragma unroll
                    for (int bj = 0; bj < 2; ++bj) { const int row = u.pm * BM + ai * HALF + wr * 64 + m * 16 + fr; const int n2 = (pn - 8) * 256 + bj * 128 + wc * 32 + 8 * fq; const int p0 = n2 & 63; const int pos = row & (SEQ - 1);
                        const f32x4* rp = rope + ((size_t)pos * 32 + 4 * (p0 >> 3)) / 2; rpv[m][bj][0] = rp[0]; rpv[m][bj][1] = rp[1]; } }
#pragma unroll
            for (int m = 0; m < 4; ++m) { const int row = u.pm * BM + ai * HALF + wr * 64 + m * 16 + fr; const float rs = C2M / sqrtf(rsv[ai][m] * (1.0f / 768.0f) + EPS);
                bf16_t* rowp = QM + (size_t)row * 3072;
#pragma unroll
                for (int bj = 0; bj < 2; ++bj) { const f32x4 x1 = acc[ai][bj][m][0] * rs, x2 = acc[ai][bj][m][1] * rs; u32x4 w; int dcol;
                    if (pn < 8) { const int n1 = pn * 256 + bj * 128 + wc * 32 + 8 * fq; dcol = (n1 >> 7) * 192 + (n1 & 127);
                        w.x = cvtpk(x1[0], x1[1]); w.y = cvtpk(x1[2], x1[3]); w.z = cvtpk(x2[0], x2[1]); w.w = cvtpk(x2[2], x2[3]);
                    } else { const int n2 = (pn - 8) * 256 + bj * 128 + wc * 32 + 8 * fq; const int hh = n2 >> 6, p0 = n2 & 63; dcol = hh * 192 + 128 + p0;
                        const f32x4 cs0 = rpv[m][bj][0], cs1 = rpv[m][bj][1];
                        const float c[4] = {cs0[0], cs0[2], cs1[0], cs1[2]}, s[4] = {cs0[1], cs0[3], cs1[1], cs1[3]};
                        float o1[4], o2[4];
#pragma unroll
                        for (int i = 0; i < 4; ++i) { o1[i] = x1[i] * c[i] - x2[i] * s[i]; o2[i] = x1[i] * s[i] + x2[i] * c[i]; }
                        w.x = cvtpk(o1[0], o1[1]); w.y = cvtpk(o1[2], o1[3]); w.z = cvtpk(o2[0], o2[1]); w.w = cvtpk(o2[2], o2[3]); }
                    *(u32x4*)(rowp + dcol) = w; } }
        }
    }
};

__device__ __forceinline__ float dpp_shr1(float v) { return __builtin_bit_cast(float, __builtin_amdgcn_update_dpp(0, __builtin_bit_cast(int, v), 0x111, 0xf, 0xf, true)); }
__device__ __forceinline__ float dpp_shr2(float v) { return __builtin_bit_cast(float, __builtin_amdgcn_update_dpp(0, __builtin_bit_cast(int, v), 0x112, 0xf, 0xf, true)); }
__device__ __forceinline__ float dpp_shl15(float v) { return __builtin_bit_cast(float, __builtin_amdgcn_update_dpp(0, __builtin_bit_cast(int, v), 0x10f, 0xf, 0xf, true)); }
__device__ __forceinline__ float dpp_shl14(float v) { return __builtin_bit_cast(float, __builtin_amdgcn_update_dpp(0, __builtin_bit_cast(int, v), 0x10e, 0xf, 0xf, true)); }
struct ConvGate {
    static constexpr bool PERM = true, AFTER_DRAIN = false;
    bf16_t* G; const float* ssq; const float* cw; const float* cb; LAS f32x4* X;
    __device__ __forceinline__ void operator()(f32x4 (&acc)[2][2][4][2], const Unit& u, int wr, int wc, int fr, int fq) const {
        const int b = u.pm / 33, bk = u.pm - 33 * b; const int tb = 254 * bk - 2;
#pragma unroll
        for (int ai = 0; ai < 2; ++ai)
#pragma unroll
            for (int m = 0; m < 4; ++m) { const int t = tb + 128 * ai + 64 * wr + 16 * m + fr; float rs = 0.f; if (t >= 0 && t < SEQ) rs = 1.0f / sqrtf(ssq[b * SEQ + t] * (1.0f / DM) + EPS);
#pragma unroll
                for (int bj = 0; bj < 2; ++bj)
#pragma unroll
                    for (int n = 0; n < 2; ++n) acc[ai][bj][m][n] *= rs; }
        LAS f32x4* PL = X + 512 + 164 + ((wr * 4 + wc) * 4 + fq) * 8;
        if (fr == 0) { const int col1 = 128 * u.pn + 32 * wc + 8 * fq + 4;
            const f32x4 q0 = *(const f32x4*)(cw + col1), q1 = *(const f32x4*)(cw + NFF2 + col1), q2 = *(const f32x4*)(cw + 2 * NFF2 + col1), q3 = *(const f32x4*)(cb + col1);
            const f32x4 q4 = *(const f32x4*)(cw + DFF + col1), q5 = *(const f32x4*)(cw + NFF2 + DFF + col1), q6 = *(const f32x4*)(cw + 2 * NFF2 + DFF + col1), q7 = *(const f32x4*)(cb + DFF + col1);
            PL[0] = q0; PL[1] = q1; PL[2] = q2; PL[3] = q3; PL[4] = q4; PL[5] = q5; PL[6] = q6; PL[7] = q7; }
        if (fr >= 14) {
#pragma unroll
            for (int ai = 0; ai < 2; ++ai)
#pragma unroll
                for (int bj = 0; bj < 2; ++bj)
#pragma unroll
                    for (int n = 0; n < 2; ++n) X[((((((2 * ai + wr) * 4 + wc) * 2 + bj) * 2 + n) * 4 + fq) * 2) + (fr - 14)] = acc[ai][bj][3][n]; }
        asm volatile("s_waitcnt lgkmcnt(0)\n\ts_barrier" ::: "memory");
#pragma unroll
        for (int n = 0; n < 2; ++n) {
            const int col = 128 * u.pn + 32 * wc + 8 * fq + 4 * n;
            f32x4 w0g, w1g, w2g, bg, w0v, w1v, w2v, bv;
            if (n == 0) { w0g = *(const f32x4*)(cw + col); w1g = *(const f32x4*)(cw + NFF2 + col); w2g = *(const f32x4*)(cw + 2 * NFF2 + col); bg = *(const f32x4*)(cb + col);
                w0v = *(const f32x4*)(cw + DFF + col); w1v = *(const f32x4*)(cw + NFF2 + DFF + col); w2v = *(const f32x4*)(cw + 2 * NFF2 + DFF + col); bv = *(const f32x4*)(cb + DFF + col); }
            else { w0g = PL[0]; w1g = PL[1]; w2g = PL[2]; bg = PL[3]; w0v = PL[4]; w1v = PL[5]; w2v = PL[6]; bv = PL[7]; }
#pragma unroll
            for (int ai = 0; ai < 2; ++ai) { const int span = 2 * ai + wr;
                f32x4 h1g = {0.f, 0.f, 0.f, 0.f}, h2g = h1g, h1v = h1g, h2v = h1g;
                if (span > 0) { const int xb0 = (((((span - 1) * 4 + wc) * 2 + 0) * 2 + n) * 4 + fq) * 2, xb1 = (((((span - 1) * 4 + wc) * 2 + 1) * 2 + n) * 4 + fq) * 2;
                    const f32x4 ga = X[xb0], gb = X[xb0 + 1], va = X[xb1], vb = X[xb1 + 1];
                    if (fr == 0) { h1g = gb; h2g = ga; h1v = vb; h2v = va; } else if (fr == 1) { h2g = gb; h2v = vb; } }
#pragma unroll
                for (int m = 0; m < 4; ++m) { const f32x4 ag = acc[ai][0][m][n], av = acc[ai][1][m][n]; f32x4 p1g, p2g, p1v, p2v;
#pragma unroll
                    for (int i = 0; i < 4; ++i) {
                        if (m == 0) { p1g[i] = dpp_shr1(ag[i]) + h1g[i]; p2g[i] = dpp_shr2(ag[i]) + h2g[i]; p1v[i] = dpp_shr1(av[i]) + h1v[i]; p2v[i] = dpp_shr2(av[i]) + h2v[i]; }
                        else { const int mm = (m == 0) ? 0 : m - 1;
                            p1g[i] = dpp_shr1(ag[i]) + dpp_shl15(acc[ai][0][mm][n][i]); p2g[i] = dpp_shr2(ag[i]) + dpp_shl14(acc[ai][0][mm][n][i]);
                            p1v[i] = dpp_shr1(av[i]) + dpp_shl15(acc[ai][1][mm][n][i]); p2v[i] = dpp_shr2(av[i]) + dpp_shl14(acc[ai][1][mm][n][i]); } }
                    const f32x4 cg_ = bg + w0g * p2g + w1g * p1g + w2g * ag, cv_ = bv + w0v * p2v + w1v * p1v + w2v * av;
                    float o[4];
#pragma unroll
                    for (int i = 0; i < 4; ++i) o[i] = cg_[i] * __builtin_amdgcn_rcpf(1.0f + __expf(-cg_[i])) * cv_[i];
                    const int ir = 128 * ai + 64 * wr + 16 * m + fr, t = tb + ir;
                    if (ir >= 2 && t < SEQ) { u32x2 w; w.x = cvtpk(o[0], o[1]); w.y = cvtpk(o[2], o[3]); *(u32x2*)(G + (size_t)(b * SEQ + t) * DFF + col) = w; } } }
        }
    }
};
}

struct ConvOrder {
    int G, c;
    __device__ __forceinline__ bool next(int i, pg8::Unit& u) const {
        const int L = i * G + c; if (L >= 4 * 33 * 22) return false;
        const int ru = L / 22; u.pn = L - 22 * ru; u.pm = ru; const int b = ru / 33, bk = ru - 33 * b; u.ar = b * SEQ + 254 * bk - 2; return true; }
    __device__ __forceinline__ void a_ready(const pg8::Unit&) const {}
    __device__ __forceinline__ void done(const pg8::Unit&) const {}
};

namespace att {
template <int DQK, int DV, bool FOX> struct Cfg {
    static constexpr int KRB = DQK * 2, VRB = DV * 2, NKC = DQK / 8, NVC = DV / 8;
    static constexpr int TR = FOX ? 128 : 64, SUBS = TR / 64;
    static constexpr int KT = TR * KRB, VT = TR * VRB, BT = FOX ? 8 * 4 * TR : 0, BUF = KT + VT + BT;
    static constexpr int DIST = 1, NBUF = 3;
    static constexpr int KPW = TR * NKC / 512, VPW = TR * NVC / 512, NDMA = KPW + VPW + (FOX ? SUBS : 0);
    static constexpr int TOTAL = NBUF * BUF;
};
__device__ __forceinline__ s16x4 vtr(const LAS unsigned char* p) { typedef short v4i16_t __attribute__((ext_vector_type(4))); return __builtin_bit_cast(s16x4, __builtin_amdgcn_ds_read_tr16_b64_v4i16((LAS v4i16_t*)p)); }
#define ATT_WAIT(N) asm volatile("s_waitcnt vmcnt(" #N ") lgkmcnt(0)\n\ts_barrier" ::: "memory")

template <int DQK, int DV, bool FOX>
__device__ __forceinline__ void attn_unit(LAS unsigned char* lds, int b, int h, int qb,
        const bf16_t* Q, int qpitch, const bf16_t* __restrict__ Kn, int kpitch, int khw, const bf16_t* __restrict__ Kr, const bf16_t* __restrict__ V, int vpitch,
        bf16_t* O, int opitch, int ohw, const float* __restrict__ cumT, const float* __restrict__ ctot, const bf16_t* wsb, bool dry) {
    using C = Cfg<DQK, DV, FOX>;
    constexpr int NKS = DQK / 16, NDB = DV / 32;
    const int tid = threadIdx.x, lane = tid & 63, wid = __builtin_amdgcn_readfirstlane(tid >> 6), r32 = lane & 31, hi = lane >> 5;
    const long rowbase = (long)b * SEQ; const int q0 = qb * 256;
    const int NT = (q0 + 256) / 64;
    const int jdiag = (q0 + 32 * wid) >> 6;
    unsigned koff[C::KPW], kstp[C::KPW], voff[C::VPW];
#pragma unroll
    for (int c = 0; c < C::KPW; ++c) { const int p = 64 * (wid + 8 * c) + lane, row = p / C::NKC, pos = p - row * C::NKC, ch = (pos & ~7) | ((pos & 7) ^ ((row >> 1) & 7));
        if (FOX || ch < 16) { koff[c] = (unsigned)((Kn - wsb) + (rowbase + row) * kpitch + h * khw + ch * 8); kstp[c] = (unsigned)C::TR * kpitch; }
        else { koff[c] = (unsigned)((Kr - wsb) + (rowbase + row) * 64 + (ch - 16) * 8); kstp[c] = (unsigned)C::TR * 64u; } }
#pragma unroll
    for (int c = 0; c < C::VPW; ++c) { const int p = 64 * (wid + 8 * c) + lane, row = p / C::NVC, pos = p - row * C::NVC;
        const int f = (DV == 128) ? (((row & 3) << 2) | ((row >> 2) & 3)) : (4 * ((row >> 1) & 1)); const int ch = pos ^ f;
        voff[c] = (unsigned)((V - wsb) + (rowbase + row) * vpitch + h * DV + ch * 8); }
    const float* csrc = FOX ? cumT + ((size_t)(b * 16 + h)) * SEQ + lane : nullptr;
#define ATT_ISSUE(j, bufo) do { \
        _Pragma("unroll") for (int c = 0; c < C::KPW; ++c) __builtin_amdgcn_global_load_lds((const unsigned*)(wsb + (koff[c] + (unsigned)(j) * kstp[c])), (LAS unsigned*)(lds + (bufo) + (wid + 8 * c) * 1024), 16, 0, 0); \
        _Pragma("unroll") for (int c = 0; c < C::VPW; ++c) __builtin_amdgcn_global_load_lds((const unsigned*)(wsb + (voff[c] + (unsigned)(j) * (unsigned)C::TR * (unsigned)vpitch)), (LAS unsigned*)(lds + (bufo) + C::KT + (wid + 8 * c) * 1024), 16, 0, 0); \
        if (FOX) { _Pragma("unroll") for (int c2 = 0; c2 < C::SUBS; ++c2) __builtin_amdgcn_global_load_lds((const unsigned*)(csrc + (j) * C::TR + 64 * c2), (LAS unsigned*)(lds + (bufo) + C::KT + C::VT + wid * (4 * C::TR) + 256 * c2), 4, 0, 0); } } while (0)
    LAS float* pre = (LAS float*)(lds + C::TOTAL);
    bf16x8 qr[NKS];
    { const bf16_t* qp = Q + (rowbase + q0 + 32 * wid + r32) * qpitch + h * DQK + 8 * hi;
#pragma unroll
      for (int ks = 0; ks < NKS; ++ks) qr[ks] = *(const bf16x8*)(qp + 16 * ks); }
    float ct = 0.f;
    if (FOX) { if (wid == 0) { const float v0 = (lane < 32) ? ctot[(b * 32 + (lane & 31)) * 16 + h] : 0.f; float s = v0;
#pragma unroll
            for (int d = 1; d < 32; d <<= 1) { const float t = __shfl_up(s, d); if (lane >= d) s += t; }
            if (lane < 32) pre[lane] = s - v0; }
        ct = cumT[((size_t)(b * 16 + h)) * SEQ + q0 + 32 * wid + r32]; }
    ATT_ISSUE(0, 0);
    ATT_WAIT(0);
#pragma unroll
    for (int ks = 0; ks < NKS; ++ks) asm volatile("" : "+v"(qr[ks]));
    asm volatile("" : "+v"(ct));
    if (FOX) ct += pre[qb];
    float m_run = 0.f, l_run = 0.f;
    f32x16 osum;
#pragma unroll
    for (int r = 0; r < 16; ++r) osum[r] = 0.f;
    const short one_ = (r32 == 0) ? (short)0x3F80 : (short)0; const bf16x8 vones = {one_, one_, one_, one_, one_, one_, one_, one_};
    f32x16 o[NDB];
#pragma unroll
    for (int d = 0; d < NDB; ++d)
#pragma unroll
        for (int r = 0; r < 16; ++r) o[d][r] = 0.f;
    const int sw = (r32 >> 1) & 7;
    int ka[4];
#pragma unroll
    for (int k = 0; k < 4; ++k) ka[k] = r32 * C::KRB + 16 * ((2 * k + hi) ^ sw);
    const int q4 = (lane >> 2) & 3, e2 = (lane >> 4) & 1, pp = lane & 3;
    int vlo[2], vdo[NDB];
    if (DV == 128) {
#pragma unroll
        for (int part = 0; part < 2; ++part) vlo[part] = (4 * hi + q4) * C::VRB + 16 * ((2 * e2 + (pp >> 1)) ^ ((hi + 2 * part) & 3)) + 8 * (pp & 1) + 8 * part * C::VRB;
#pragma unroll
        for (int d = 0; d < NDB; ++d) vdo[d] = 64 * (d ^ q4);
    } else {
#pragma unroll
        for (int part = 0; part < 2; ++part) vlo[part] = (4 * hi + q4) * C::VRB + 16 * (2 * e2 + (pp >> 1)) + 8 * (pp & 1) + 8 * part * C::VRB;
#pragma unroll
        for (int d = 0; d < NDB; ++d) vdo[d] = 64 * (d ^ (q4 >> 1));
    }
    const bool odd = wid >= 4;
    f32x16 p0, p1;
#define ATT_SCORES(jj, boff, sub) do { \
        const LAS unsigned char* Kb = lds + (boff) + (sub) * 64 * C::KRB; \
        if (FOX) { const LAS float* bb = (const LAS float*)(lds + (boff) + C::KT + C::VT) + 64 * (sub) + 4 * hi; const float cm = ct - m_run - pre[(jj) >> 2]; \
            _Pragma("unroll") for (int g4 = 0; g4 < 4; ++g4) { const f32x4 c0 = *(const LAS f32x4*)(bb + 8 * g4), c1 = *(const LAS f32x4*)(bb + 32 + 8 * g4); \
                _Pragma("unroll") for (int i = 0; i < 4; ++i) { p0[4 * g4 + i] = cm - c0[i]; p1[4 * g4 + i] = cm - c1[i]; } } \
        } else { _Pragma("unroll") for (int r = 0; r < 16; ++r) { p0[r] = 0.f; p1[r] = 0.f; } } \
        _Pragma("unroll") for (int ks = 0; ks < NKS; ++ks) { const bf16x8 k0 = *(const LAS bf16x8*)(Kb + ka[ks & 3] + 128 * (ks >> 2)); p0 = __builtin_amdgcn_mfma_f32_32x32x16_bf16(k0, qr[ks], p0, 0, 0, 0); } \
        _Pragma("unroll") for (int ks = 0; ks < NKS; ++ks) { const bf16x8 k1 = *(const LAS bf16x8*)(Kb + ka[ks & 3] + 32 * C::KRB + 128 * (ks >> 2)); p1 = __builtin_amdgcn_mfma_f32_32x32x16_bf16(k1, qr[ks], p1, 0, 0, 0); } \
        __builtin_amdgcn_sched_group_barrier(0x100, FOX ? 12 : 4, 0); \
        _Pragma("unroll") for (int i_ = 0; i_ < 2 * NKS - 4; ++i_) { __builtin_amdgcn_sched_group_barrier(0x008, 1, 0); __builtin_amdgcn_sched_group_barrier(0x100, 1, 0); } \
        __builtin_amdgcn_sched_group_barrier(0x008, 4, 0); \
        if (FOX && (jj) == jdiag) { const int qa = q0 + 32 * wid + r32, kvb = 64 * (jj) + 4 * hi; \
            _Pragma("unroll") for (int r = 0; r < 16; ++r) { const int kv = kvb + (r & 3) + 8 * (r >> 2); if (kv > qa) p0[r] = -1e30f; if (kv + 32 > qa) p1[r] = -1e30f; } } \
    } while (0)
#define ATT_HALF(P, PO, HALF, HAVE_OTHER, jj, Vb) do { \
        float mx = __builtin_fmaxf(P[0], P[1]); \
        _Pragma("unroll") for (int r = 2; r < 16; r += 2) mx = __builtin_fmaxf(__builtin_fmaxf(mx, P[r]), P[r + 1]); \
        { auto rr_ = __builtin_amdgcn_permlane32_swap(__float_as_uint(mx), __float_as_uint(mx), false, false); mx = __builtin_fmaxf(__uint_as_float(rr_[0]), __uint_as_float(rr_[1])); } \
        const float rel = FOX ? mx : mx - m_run; const bool first = ((jj) == 0 && HALF == 0); \
        if (__any(first || rel > 8.0f)) { const float delta = first ? rel : __builtin_fmaxf(rel, 0.f); m_run += delta; const float alpha = first ? 1.0f : __builtin_amdgcn_exp2f(-delta); l_run *= alpha; \
            _Pragma("unroll") for (int d = 0; d < NDB; ++d) _Pragma("unroll") for (int r = 0; r < 16; ++r) o[d][r] *= alpha; \
            if (FOX) { osum[0] *= alpha; _Pragma("unroll") for (int r = 0; r < 16; ++r) { P[r] -= delta; if (HAVE_OTHER) PO[r] -= delta; } } } \
        float sum = 0.f; \
        _Pragma("unroll") for (int r = 0; r < 16; ++r) { P[r] = __builtin_amdgcn_exp2f(FOX ? P[r] : P[r] - m_run); if (!FOX) sum += P[r]; } \
        l_run += sum; \
        u32x4 w0, w1; \
        w0.x = cvtpk(P[0], P[1]); w0.y = cvtpk(P[2], P[3]); w0.z = cvtpk(P[4], P[5]); w0.w = cvtpk(P[6], P[7]); \
        w1.x = cvtpk(P[8], P[9]); w1.y = cvtpk(P[10], P[11]); w1.z = cvtpk(P[12], P[13]); w1.w = cvtpk(P[14], P[15]); \
        const bf16x8 pk0 = __builtin_bit_cast(bf16x8, w0), pk1 = __builtin_bit_cast(bf16x8, w1); \
        if (FOX) { osum = __builtin_amdgcn_mfma_f32_32x32x16_bf16(vones, pk0, osum, 0, 0, 0); osum = __builtin_amdgcn_mfma_f32_32x32x16_bf16(vones, pk1, osum, 0, 0, 0); } \
        _Pragma("unroll") for (int d = 0; d < NDB; ++d) { const s16x4 lo = vtr(Vb + vlo[0] + vdo[d] + (32 * HALF) * C::VRB), h8 = vtr(Vb + vlo[1] + vdo[d] + (32 * HALF) * C::VRB); \
            const bf16x8 vf = {lo[0], lo[1], lo[2], lo[3], h8[0], h8[1], h8[2], h8[3]}; o[d] = __builtin_amdgcn_mfma_f32_32x32x16_bf16(vf, pk0, o[d], 0, 0, 0); } \
        _Pragma("unroll") for (int d = 0; d < NDB; ++d) { const s16x4 lo = vtr(Vb + vlo[0] + vdo[d] + (32 * HALF + 16) * C::VRB), h8 = vtr(Vb + vlo[1] + vdo[d] + (32 * HALF + 16) * C::VRB); \
            const bf16x8 vf = {lo[0], lo[1], lo[2], lo[3], h8[0], h8[1], h8[2], h8[3]}; o[d] = __builtin_amdgcn_mfma_f32_32x32x16_bf16(vf, pk1, o[d], 0, 0, 0); } \
    } while (0)
#define ATT_SPV(jj, boff, sub) do { const LAS unsigned char* Vb_ = lds + (boff) + C::KT + (sub) * 64 * C::VRB; ATT_HALF(p0, p1, 0, true, jj, Vb_); ATT_HALF(p1, p0, 1, false, jj, Vb_); } while (0)
    int bcur = 0, bnext = C::BUF;
    const int NTT = NT / C::SUBS;
    for (int jt = 0; jt < NTT; ++jt) {
        if (jt + 1 < NTT) ATT_ISSUE(jt + 1, bnext);
#pragma unroll
        for (int sub = 0; sub < C::SUBS; ++sub) {
            const int j = jt * C::SUBS + sub;
            const bool act = (j <= jdiag);
            if (act) ATT_SCORES(j, bcur, sub);
            if (!FOX && odd) ATT_WAIT(0);
            if (act) ATT_SPV(j, bcur, sub);
        }
        if (FOX || !odd) ATT_WAIT(0);
        bcur = bnext; bnext += C::BUF; if (bnext == C::TOTAL) bnext = 0;
    }
    ATT_WAIT(0);
#undef ATT_SCORES
#undef ATT_HALF
#undef ATT_SPV
#undef ATT_ISSUE
    if (FOX) l_run = osum[0];
    { auto rr_ = __builtin_amdgcn_permlane32_swap(__float_as_uint(l_run), __float_as_uint(l_run), false, false); l_run = __uint_as_float(rr_[0]) + __uint_as_float(rr_[1]); }
    const float inv = 1.0f / l_run;
    constexpr int SRB = DV * 2 + 16, CPR = DV / 8, RPI = 64 / CPR;
    LAS unsigned char* stg = lds + C::BUF + wid * (32 * SRB);
#pragma unroll
    for (int d = 0; d < NDB; ++d)
#pragma unroll
        for (int rg = 0; rg < 4; ++rg) { u32x2 w; w.x = cvtpk(o[d][4 * rg] * inv, o[d][4 * rg + 1] * inv); w.y = cvtpk(o[d][4 * rg + 2] * inv, o[d][4 * rg + 3] * inv);
            *(LAS u32x2*)(stg + r32 * SRB + (d * 32 + 8 * rg + 4 * hi) * 2) = w; }
    asm volatile("s_waitcnt lgkmcnt(0)" ::: "memory");
    bf16_t* ob = dry ? (bf16_t*)wsb + ((FOX ? 256 : 28) * MiB / 2) + (size_t)(32 * wid) * opitch + h * ohw : O + (rowbase + q0 + 32 * wid) * opitch + h * ohw;
#pragma unroll
    for (int it = 0; it < 32 / RPI; ++it) { const int row = it * RPI + lane / CPR, ch = lane % CPR;
        const u32x4 v = *(const LAS u32x4*)(stg + row * SRB + ch * 16);
        *(u32x4*)(ob + (size_t)row * opitch + ch * 8) = v; }
}

template <int DQK, int DV, bool FOX, class F>
__device__ __forceinline__ void attn_phase(int G, int bx, F&& run) {
    if (G == 256) { const int vcu = (bx & 7) * 32 + (bx >> 3); const int bh = vcu >> 2, s = vcu & 3;
        for (int i = 0; i < 8; ++i) { const int qb = (i & 1) ? (8 * (i >> 1) + 7 - s) : (8 * (i >> 1) + s); run(bh >> 4, bh & 15, 31 - qb); }
    } else { for (int L = bx; L < 2048; L += G) run(L >> 9, (L >> 5) & 15, 31 - (L & 31)); }
}
}

#define XB_TMO      128
#define XB_XCNT(j)  (256  + 64 * (j))
#define XB_XSUB(j)  (1280 + 64 * (j))
#define XB_XGEN(j)  (2304 + 64 * (j))
#define XB_TOP      3328
#define XB_TOPGEN   3392
#define XCD_BAR_WORDS 3456
#define XB_SPIN_CAP (1u << 18)

__device__ __forceinline__ unsigned xb_ld(unsigned* p)              { return __hip_atomic_load(p, __ATOMIC_RELAXED, __HIP_MEMORY_SCOPE_AGENT); }
__device__ __forceinline__ unsigned xb_add(unsigned* p, unsigned v) { return __hip_atomic_fetch_add(p, v, __ATOMIC_RELAXED, __HIP_MEMORY_SCOPE_AGENT); }
__device__ __forceinline__ unsigned xb_xcc_id() { return (unsigned)__builtin_amdgcn_s_getreg((3 << 11) | 20) & 0xFu; }
#define XB_SPIN(cond, bar) do { unsigned _sp = 0; while (cond) { __builtin_amdgcn_s_sleep(1); \
    if ((++_sp & 255u) == 0u) { if (xb_ld(&(bar)[XB_TMO])) break; if (_sp > XB_SPIN_CAP) { atomicAdd(&(bar)[XB_TMO], 1u); break; } } } } while (0)

struct XcdBarrier {
    unsigned* bar; unsigned x;
    volatile LAS unsigned* st;
};

__device__ __forceinline__ XcdBarrier xcd_barrier_post(unsigned* bar, volatile LAS unsigned* st) {
    XcdBarrier b; b.bar = bar; b.x = xb_xcc_id(); b.st = st;
    if (threadIdx.x == 0) (void)xb_add(&bar[XB_XCNT(b.x)], 1u);
    return b;
}
__device__ __forceinline__ void xcd_barrier_complete(unsigned* bar, unsigned x, unsigned& nloc, unsigned& nx) {
    const unsigned G = gridDim.x * gridDim.y * gridDim.z;
    unsigned sum, cnt, mine, sp = 0u;
    for (;;) {
        sum = 0u; cnt = 0u; mine = 0u;
#pragma unroll
        for (unsigned j = 0; j < 16; ++j) { const unsigned c = xb_ld(&bar[XB_XCNT(j)]); sum += c; cnt += (c > 0u) ? 1u : 0u; mine = (j == x) ? c : mine; }
        if (sum == G) break;
        __builtin_amdgcn_s_sleep(1);
        if ((++sp & 255u) == 0u) { if (xb_ld(&bar[XB_TMO])) break; if (sp > XB_SPIN_CAP) { atomicAdd(&bar[XB_TMO], 1u); break; } }
    }
    nloc = mine > 0u ? mine : 1u; nx = cnt > 0u ? cnt : 1u;
}

__device__ __forceinline__ void xcd_barrier(const XcdBarrier& b) {
    asm volatile("s_waitcnt vmcnt(0)" ::: "memory");
    __syncthreads();
    if (threadIdx.x == 0) {
        unsigned* bar = b.bar;
        __builtin_amdgcn_s_waitcnt(0);
        unsigned nloc = b.st[0], nx = b.st[1];
        if (nloc == 0u) { xcd_barrier_complete(bar, b.x, nloc, nx); b.st[0] = nloc; b.st[1] = nx; }
        const unsigned old = xb_add(&bar[XB_XSUB(b.x)], 1u);
        const unsigned gen = old / nloc;
        if (old + 1u == (gen + 1u) * nloc) {
            __builtin_amdgcn_fence(__ATOMIC_RELEASE, "agent");
            asm volatile("s_waitcnt vmcnt(0)" ::: "memory");
            const unsigned og = xb_add(&bar[XB_TOP], 1u);
            const unsigned tg = og / nx;
            if (og + 1u == (tg + 1u) * nx) xb_add(&bar[XB_TOPGEN], 1u);
            else XB_SPIN(xb_ld(&bar[XB_TOPGEN]) == tg, bar);
            __builtin_amdgcn_fence(__ATOMIC_ACQUIRE, "agent");
            xb_add(&bar[XB_XGEN(b.x)], 1u);
            asm volatile("s_waitcnt vmcnt(0)" ::: "memory");
        } else {
            XB_SPIN(xb_ld(&bar[XB_XGEN(b.x)]) == gen, bar);
            __builtin_amdgcn_fence(__ATOMIC_ACQUIRE, "agent");
            asm volatile("s_waitcnt vmcnt(0)" ::: "memory");
        }
    }
    __syncthreads();
}

constexpr int NPHASE = 14;
struct Args { const float* in[21]; float* out; unsigned char* ws; int ph_lo, ph_hi, probe, pad; };

__global__ void __launch_bounds__(512, 2) mega_fwd(Args a) {
    extern __shared__ __attribute__((aligned(16))) unsigned char lds_raw[];
    LAS unsigned char* lds = (LAS unsigned char*)lds_raw;
    cg::grid_group grid = cg::this_grid();
    P p;
    p.x = a.in[0]; p.fox_norm = a.in[1]; p.w_fox_in = a.in[2]; p.b_fox_f = a.in[3]; p.w_fox_out = a.in[4]; p.kv_in_norm = a.in[5]; p.w_dkv = a.in[6]; p.kv_norm = a.in[7];
    p.w_uk = a.in[8]; p.w_uv = a.in[9]; p.mla_norm = a.in[10]; p.w_dq = a.in[11]; p.q_norm = a.in[12]; p.w_uq = a.in[13]; p.w_mla_out = a.in[14]; p.ffn_norm = a.in[15];
    p.w_ffn_in = a.in[16]; p.ffn_conv_w = a.in[17]; p.ffn_conv_b = a.in[18]; p.w_ffn_out = a.in[19]; p.final_norm = a.in[20]; p.out = a.out; p.ws = a.ws;
    unsigned char* ws = a.ws;
    const int tid = threadIdx.x, wave = tid >> 6, G = gridDim.x, bx = blockIdx.x;
    const int gw = bx * 8 + wave, NGW = G * 8, gtid = bx * 512 + tid, NGT = G * 512;
    const int lo = a.ph_lo, hi = a.ph_hi;
    volatile LAS unsigned* bst = (volatile LAS unsigned*)(lds + LDS_MISC + 2048);
    if (tid < 2) bst[tid] = 0u;
    __syncthreads();
    XcdBarrier bar; bar.bar = (unsigned*)ws; bar.x = 0; bar.st = bst;
    if (bx == 0) { for (int i = tid; i < XCD_BAR_WORDS; i += 512) ((unsigned*)ws)[i] = 0u; }
#ifndef PHMASK
#define PHMASK 0xffff
#endif
#define IN(k) (((PHMASK >> (k)) & 1) && lo <= (k) && (k) < hi)
#define SEAM(k) do { if (IN(k) && IN((k) + 1)) { if ((k) == 0) { grid.sync(); bar = xcd_barrier_post((unsigned*)ws, bst); } else xcd_barrier(bar); } } while (0)
    bf16_t* XB = (bf16_t*)(ws + WS_XB);
    float* SSQ1 = (float*)(ws + WS_SSQ1); float* SSQ2 = (float*)(ws + WS_SSQ2); float* SSQ3 = (float*)(ws + WS_SSQ3); float* SSQQ = (float*)(ws + WS_SSQQ); float* SSQL = (float*)(ws + WS_SSQL);
    const f32x4* ROPE = (const f32x4*)(ws + WS_ROPE);

    if (IN(0)) { phase_prologue(p, lds, gw, NGW, gtid, NGT, 3);
#if (MK_PROBE & 3)
        __syncthreads(); phase_prologue(p, lds, gw, NGW, gtid, NGT, a.probe & 3);
#endif
    }
    SEAM(0);
    if (IN(1)) {
        for (int c = bx; c < 128; c += G) chunk_scan(p, lds, c);
        pg8::Gemm g{XB, (const bf16_t*)(ws + WS_WQKV), M, 3072, 1024, 1024}; pg8::StaticOrder S; S.init(M, 3072, G, bx);
        epi::RowScaleSplit E{(bf16_t*)(ws + WS_Q0), 1024, 1024, (size_t)(WS_K0 - WS_Q0) / 2, C2F, (const float*)(ws + WS_RSTD0), 0.f, 1};
        pg8::gemm_phase<epi::RowScaleSplit, pg8::StaticOrder, true, true>(lds, g, S, E);
    }
    SEAM(1);
    if (IN(2)) {
        const bf16_t* Qp = (const bf16_t*)(ws + WS_Q0); const bf16_t* Kp = (const bf16_t*)(ws + WS_K0); const bf16_t* Vp = (const bf16_t*)(ws + WS_V0);
        const float* cumT = (const float*)(ws + WS_CUMT); const float* ctot = (const float*)(ws + WS_CTOT);
#if (MK_PROBE >> 2) & 1
        { const bool dry = a.probe != 0;
        att::attn_phase<64, 64, true>(G, bx, [&](int b, int h, int qb) {
            att::attn_unit<64, 64, true>(lds, b, h, qb, Qp, 1024, Kp, 1024, 64, nullptr, Vp, 1024, (bf16_t*)(ws + WS_Q0), 1024, 64, cumT, ctot, (const bf16_t*)ws, dry); }); }
#endif
        att::attn_phase<64, 64, true>(G, bx, [&](int b, int h, int qb) {
            att::attn_unit<64, 64, true>(lds, b, h, qb, Qp, 1024, Kp, 1024, 64, nullptr, Vp, 1024, (bf16_t*)(ws + WS_Q0), 1024, 64, cumT, ctot, (const bf16_t*)ws, false); });
    }
    SEAM(2);
    if (IN(3)) {
        pg8::Gemm g{(const bf16_t*)(ws + WS_Q0), (const bf16_t*)(ws + WS_WFO), M, 1024, 1024, 1024}; pg8::StaticOrder S; S.init(M, 1024, G, bx);
        epi::Residual E{p.x, p.out, XB, SSQ1};
        pg8::gemm_phase<epi::Residual, pg8::StaticOrder, true, true>(lds, g, S, E);
    }
    SEAM(3);
    if (IN(4)) {
        pg8::Gemm g{XB, (const bf16_t*)(ws + WS_WFI0), M, NFF2, 1024, 1024}; ConvOrder S{G, bx};
        epi::ConvGate E{(bf16_t*)(ws + WS_G), SSQ1, p.ffn_conv_w, p.ffn_conv_b, (LAS f32x4*)(lds + LDS_XCH)};
        pg8::gemm_phase<epi::ConvGate, ConvOrder, true, true>(lds, g, S, E);
    }
    SEAM(4);
    if (IN(5)) {
        pg8::Gemm g{(const bf16_t*)(ws + WS_G), (const bf16_t*)(ws + WS_WFD0), M, 1024, DFF, DFF}; pg8::StaticOrder S; S.init(M, 1024, G, bx);
        epi::Residual E{p.out, p.out, XB, SSQ2};
        pg8::gemm_phase<epi::Residual, pg8::StaticOrder, true, true>(lds, g, S, E);
    }
    SEAM(5);
    if (IN(6)) {
        pg8::Gemm g{XB, (const bf16_t*)(ws + WS_WDN), M, 1280, 1024, 1024}; pg8::StaticOrder S; S.init(M, 1280, G, bx);
        epi::MlaDown E{SSQ2, (bf16_t*)(ws + WS_CQ), (bf16_t*)(ws + WS_LAT), (bf16_t*)(ws + WS_KR), SSQQ, SSQL, ROPE};
        pg8::gemm_phase<epi::MlaDown, pg8::StaticOrder, true, true>(lds, g, S, E);
    }
    SEAM(6);
    if (IN(7)) {
        pg8::Gemm g{(const bf16_t*)(ws + WS_CQ), (const bf16_t*)(ws + WS_WUQ), M, 3072, 768, 768}; pg8::StaticOrder S; S.init(M, 3072, G, bx);
        epi::MlaUq E{SSQQ, (bf16_t*)(ws + WS_QM), ROPE};
        pg8::gemm_phase<epi::MlaUq, pg8::StaticOrder, true, true>(lds, g, S, E);
    }
    SEAM(7);
    if (IN(8)) {
        pg8::Gemm g{(const bf16_t*)(ws + WS_LAT), (const bf16_t*)(ws + WS_WUKV), M, 4096, 256, 256}; pg8::StaticOrder S; S.init(M, 4096, G, bx);
        epi::RowScaleSplit E{(bf16_t*)(ws + WS_KN), 2048, 2048, (size_t)(WS_VM - WS_KN) / 2, 1.f, SSQL, 1.0f / 256.0f, 0};
        pg8::gemm_phase<epi::RowScaleSplit, pg8::StaticOrder, true, true>(lds, g, S, E);
    }
    SEAM(8);
    if (IN(9)) {
        const bf16_t* Qp = (const bf16_t*)(ws + WS_QM); const bf16_t* Kp = (const bf16_t*)(ws + WS_KN); const bf16_t* Krp = (const bf16_t*)(ws + WS_KR); const bf16_t* Vp = (const bf16_t*)(ws + WS_VM);
#if (MK_PROBE >> 9) & 1
        { const bool dry = a.probe != 0;
        att::attn_phase<192, 128, false>(G, bx, [&](int b, int h, int qb) {
            att::attn_unit<192, 128, false>(lds, b, h, qb, Qp, 3072, Kp, 2048, 128, Krp, Vp, 2048, (bf16_t*)(ws + WS_QM), 3072, 192, nullptr, nullptr, (const bf16_t*)ws, dry); }); }
#endif
        att::attn_phase<192, 128, false>(G, bx, [&](int b, int h, int qb) {
            att::attn_unit<192, 128, false>(lds, b, h, qb, Qp, 3072, Kp, 2048, 128, Krp, Vp, 2048, (bf16_t*)(ws + WS_QM), 3072, 192, nullptr, nullptr, (const bf16_t*)ws, false); });
    }
    SEAM(9);
    if (IN(10)) {
        pg8::Gemm g{(const bf16_t*)(ws + WS_QM), (const bf16_t*)(ws + WS_WMO), M, 1024, 2048, 3072}; pg8::StaticOrder S; S.init(M, 1024, G, bx);
        epi::Residual E{p.out, p.out, XB, SSQ3};
        pg8::gemm_phase<epi::Residual, pg8::StaticOrder, true, true, 1>(lds, g, S, E);
    }
    SEAM(10);
    if (IN(11)) {
        pg8::Gemm g{XB, (const bf16_t*)(ws + WS_WFI1), M, NFF2, 1024, 1024}; ConvOrder S{G, bx};
        epi::ConvGate E{(bf16_t*)(ws + WS_G), SSQ3, p.ffn_conv_w + 3 * NFF2, p.ffn_conv_b + NFF2, (LAS f32x4*)(lds + LDS_XCH)};
        pg8::gemm_phase<epi::ConvGate, ConvOrder, true, true>(lds, g, S, E);
    }
    SEAM(11);
    if (IN(12)) {
        pg8::Gemm g{(const bf16_t*)(ws + WS_G), (const bf16_t*)(ws + WS_WFD1), M, 1024, DFF, DFF}; pg8::StaticOrder S; S.init(M, 1024, G, bx);
        epi::Residual E{p.out, p.out, nullptr, nullptr};
        pg8::gemm_phase<epi::Residual, pg8::StaticOrder, true, true>(lds, g, S, E);
    }
    SEAM(12);
    if (IN(13)) { phase_final(p, gw, NGW); }
#undef IN
#undef SEAM
}

#ifndef MK_COOP
#define MK_COOP 1
#endif
extern "C" void kernel_launch(void* const* d_in, const int* in_sizes, int n_in, void* d_out, int out_size, void* d_ws, size_t ws_size, hipStream_t stream) {
    static int grid = 0;
    if (grid == 0) {
        if (n_in != 21 || in_sizes[0] != M * DM || out_size != M * DM || ws_size < WS_END) { fprintf(stderr, "kernel_launch: unexpected shapes (n_in %d, in0 %d, out %d, ws %zu)\n", n_in, n_in > 0 ? in_sizes[0] : -1, out_size, ws_size); grid = -1; return; }
        int dev = 0, cus = 0, per_cu = 0;
        hipGetDevice(&dev); hipDeviceGetAttribute(&cus, hipDeviceAttributeMultiprocessorCount, dev);
        if (hipFuncSetAttribute((const void*)mega_fwd, hipFuncAttributeMaxDynamicSharedMemorySize, LDS_BYTES) != hipSuccess) { fprintf(stderr, "kernel_launch: hipFuncSetAttribute failed\n"); grid = -1; return; }
        if (hipOccupancyMaxActiveBlocksPerMultiprocessor(&per_cu, (const void*)mega_fwd, 512, LDS_BYTES) != hipSuccess || per_cu < 1) { fprintf(stderr, "kernel_launch: occupancy query says %d\n", per_cu); per_cu = 1; }
        (void)hipGetLastError();
        grid = cus * per_cu;
    }
    if (grid < 0) return;
    Args a{};
    for (int i = 0; i < 21; ++i) a.in[i] = (const float*)d_in[i];
    a.out = (float*)d_out; a.ws = (unsigned char*)d_ws; a.probe = MK_PROBE;
#if MK_COOP
    a.ph_lo = 0; a.ph_hi = NPHASE;
    void* args[] = {&a};
    hipError_t e = hipLaunchCooperativeKernel((const void*)mega_fwd, dim3(grid), dim3(512), args, LDS_BYTES, stream);
    if (e != hipSuccess) fprintf(stderr, "cooperative launch failed: %s (grid %d)\n", hipGetErrorString(e), grid);
#else
    for (int ph = 0; ph < NPHASE; ++ph) { a.ph_lo = ph; a.ph_hi = ph + 1; hipLaunchKernelGGL(mega_fwd, dim3(grid), dim3(512), LDS_BYTES, stream, a); }
#endif
}
```

```cpp
#include <hip/hip_runtime.h>
#include <hip/hip_cooperative_groups.h>
#include <cstdio>
#include <cstdint>
namespace cg = cooperative_groups;
#ifndef ATT_SGB
#define ATT_SGB 1
#endif
#ifndef MK_PROBE
#define MK_PROBE 0
#endif
namespace pg8 {
#define PG8_LAS __attribute__((address_space(3)))
typedef unsigned short bf16_t;
typedef short bf16x8 __attribute__((ext_vector_type(8)));
typedef float f32x4 __attribute__((ext_vector_type(4)));
typedef unsigned u32x4 __attribute__((ext_vector_type(4)));
constexpr int BM = 256, BK = 64, HALF = 128, HTB = HALF * BK * 2  , STAGE_BYTES = 8 * HTB, NXCD = 8, WGM = 8;

__host__ __device__ __forceinline__ int lds_byte(int r, int c) { const int st = (r >> 4) * 2 + (c >> 5), rr = r & 15, cc = c & 31, ob = rr * 64 + cc * 2; return st * 1024 + (ob ^ (((ob >> 9) & 1) << 5)); }
__host__ __device__ __forceinline__ void stage_rc(int b, int& R, int& C) { const int st = b / 1024, sb = b % 1024, swz = sb ^ (((sb >> 9) & 1) << 5); R = (st >> 1) * 16 + swz / 64; C = (st & 1) * 32 + (swz % 64) / 2; }
__host__ __device__ __forceinline__ int perm32(int rho) { const int n = rho >> 4, i = rho & 15; return 8 * (i >> 2) + 4 * n + (i & 3); }

struct Unit { int pm, pn, ar; };
struct Gemm { const bf16_t* A; const bf16_t* Bt; int M, N, K, lda; };

struct StaticOrder {
    int nM, nN, nwg, G, c;
    __host__ __device__ void init(int M, int N, int G_, int c_) { nM = M / BM; nN = N / BM; nwg = nM * nN; G = G_; c = c_; }
    __host__ __device__ bool next(int i, Unit& u) const {
        const long L = (long)i * G + c; if (L >= nwg) return false;
        int wgid = (int)L; { const int q = nwg / NXCD, r = nwg % NXCD, xcd = wgid % NXCD, off = wgid / NXCD; wgid = (xcd < r ? xcd * (q + 1) : r * (q + 1) + (xcd - r) * q) + off; }
        const int nig = WGM * nN, gid = wgid / nig, fm = gid * WGM, gsz = (nM - fm) < WGM ? (nM - fm) : WGM;
        u.pm = fm + ((wgid % nig) % gsz); u.pn = (wgid % nig) / gsz; u.ar = u.pm * BM; return true;
    }
    __device__ __forceinline__ void a_ready(const Unit&) const {}
    __device__ __forceinline__ void done(const Unit&) const {}
};

template <class Epi, class Sched, bool ALIGN_EPI = false, bool SP2 = false, int AMAP = 0>
__device__ __forceinline__ void gemm_phase(PG8_LAS unsigned char* lds, const Gemm g, const Sched& S, const Epi& E) {
    const int tid = threadIdx.x, wid = __builtin_amdgcn_readfirstlane(tid >> 6), lane = tid & 63, wr = wid >> 2, wc = wid & 3, fr = lane & 15, fq = lane >> 4;
    const int K = g.K, nt = K / BK;
    unsigned voffA[2], voffB[2];
#pragma unroll
    for (int i = 0; i < 2; ++i) { int R, C; stage_rc(tid * 16 + i * 8192, R, C); const int Rb = Epi::PERM ? ((R & ~31) + perm32(R & 31)) : R;
        voffA[i] = (unsigned)(R * g.lda + C) * 2u; voffB[i] = (unsigned)(Rb * K + C) * 2u; }
    const size_t kstep = (size_t)(BK * 2);
    const size_t hstepB = (size_t)HALF * K * 2, hstepA = (size_t)HALF * g.lda * 2;
    const size_t tstep = 2 * hstepB;
    const unsigned ldsw = (unsigned)wid * 1024u;
    const int aoff = lds_byte(wr * 64 + fr, fq * 8), boff = lds_byte(wc * 32 + fr, fq * 8);
#define PG8_AK(t) ((size_t)(AMAP == 1 ? ((((t) >> 1) * 192 + ((t) & 1) * 64) * 2) : ((t) * (BK * 2))))
#define PG8_SA(b, h) (((b) * 2 + (h)) * HTB)
#define PG8_SB(b, h) ((4 + (b) * 2 + (h)) * HTB)
#define PG8_STAGE(bufoff, gbase, voff) do { _Pragma("unroll") for (int _i = 0; _i < 2; ++_i) \
        __builtin_amdgcn_global_load_lds((const unsigned*)((const char*)(gbase) + (voff)[_i]), (PG8_LAS unsigned*)(lds + (bufoff) + ldsw + _i * 8192), 16, 0, 0); } while (0)
#define PG8_LDA(dst, b, h) do { _Pragma("unroll") for (int m = 0; m < 4; ++m) _Pragma("unroll") for (int k = 0; k < 2; ++k) dst[m][k] = *(const PG8_LAS bf16x8*)(lds + PG8_SA(b, h) + aoff + m * 2048 + k * 1024); } while (0)
#define PG8_LDB(dst, b, h) do { _Pragma("unroll") for (int n = 0; n < 2; ++n) _Pragma("unroll") for (int k = 0; k < 2; ++k) dst[n][k] = *(const PG8_LAS bf16x8*)(lds + PG8_SB(b, h) + boff + n * 2048 + k * 1024); } while (0)
#define PG8_MMA(ai, bj, At, Bt) do { __builtin_amdgcn_s_setprio(1); _Pragma("unroll") for (int m = 0; m < 4; ++m) _Pragma("unroll") for (int n = 0; n < 2; ++n) _Pragma("unroll") for (int k = 0; k < 2; ++k) \
        acc[ai][bj][m][n] = __builtin_amdgcn_mfma_f32_16x16x32_bf16(Bt[n][k], At[m][k], acc[ai][bj][m][n], 0, 0, 0); __builtin_amdgcn_s_setprio(0); } while (0)
#define PG8_WAIT_V(n) asm volatile("s_waitcnt vmcnt(" #n ")" ::: "memory")
#define PG8_WAIT_L(n) asm volatile("s_waitcnt lgkmcnt(" #n ")" ::: "memory")
#define PG8_BAR __builtin_amdgcn_s_barrier()
#define PG8_SCHED __builtin_amdgcn_sched_barrier(0)
    Unit cur, nxt; int ui = 0;
    if (!S.next(0, cur)) return;
    f32x4 acc[2][2][4][2];
#pragma unroll
    for (int a = 0; a < 2; ++a)
#pragma unroll
        for (int b = 0; b < 2; ++b)
#pragma unroll
            for (int m = 0; m < 4; ++m)
#pragma unroll
                for (int n = 0; n < 2; ++n) acc[a][b][m][n] = (f32x4){0.f, 0.f, 0.f, 0.f};
    bf16x8 At[4][2], B0[2][2], B1[2][2];
    const char* cA = (const char*)g.A + (long)cur.ar * (long)g.lda * 2; const char* cB = (const char*)g.Bt + (size_t)cur.pn * tstep;
    S.a_ready(cur);
    if constexpr (SP2) {
        PG8_STAGE(PG8_SB(0, 0), cB, voffB); PG8_STAGE(PG8_SB(0, 1), cB + hstepB, voffB); PG8_STAGE(PG8_SA(0, 0), cA, voffA); PG8_STAGE(PG8_SA(0, 1), cA + hstepA, voffA);
        if (wr == 1) PG8_BAR;
        PG8_WAIT_V(2); PG8_BAR;
        PG8_STAGE(PG8_SB(1, 0), cB + kstep, voffB); PG8_STAGE(PG8_SA(1, 0), cA + PG8_AK(1), voffA); PG8_STAGE(PG8_SB(1, 1), cB + hstepB + kstep, voffB);
        PG8_WAIT_V(6); PG8_BAR;
    } else {
        PG8_STAGE(PG8_SB(0, 0), cB, voffB); PG8_STAGE(PG8_SA(0, 0), cA, voffA); PG8_STAGE(PG8_SB(0, 1), cB + hstepB, voffB); PG8_STAGE(PG8_SA(0, 1), cA + hstepA, voffA);
        if (wr == 1) PG8_BAR;
        PG8_WAIT_V(4); PG8_BAR;
        PG8_STAGE(PG8_SB(1, 0), cB + kstep, voffB); PG8_STAGE(PG8_SA(1, 0), cA + PG8_AK(1), voffA); PG8_STAGE(PG8_SB(1, 1), cB + hstepB + kstep, voffB);
        PG8_WAIT_V(6); PG8_BAR;
    }
    for (;;) {
        const bool has_next = S.next(ui + 1, nxt);
        const char* nA = has_next ? (const char*)g.A + (long)nxt.ar * (long)g.lda * 2 : cA; const char* nB = has_next ? (const char*)g.Bt + (size_t)nxt.pn * tstep : cB;
        for (int t = 0; t < nt; t += 2) {
            const bool last = (t == nt - 2);
            const char* a1 = cA + PG8_AK(t + 1);
            const char* a2 = last ? nA : cA + PG8_AK(t + 2); const char* b2 = last ? nB : cB + (size_t)(t + 2) * kstep;
            const char* a3 = last ? nA + PG8_AK(1) : cA + PG8_AK(t + 3); const char* b3 = b2 + kstep;
            if (last && has_next) S.a_ready(nxt);
            if constexpr (SP2) {
            PG8_LDB(B0, 0, 0); PG8_LDB(B1, 0, 1); PG8_SCHED; PG8_LDA(At, 0, 0); PG8_STAGE(PG8_SA(1, 1), a1 + hstepA, voffA);
            PG8_WAIT_V(8); PG8_WAIT_L(0); PG8_BAR; PG8_MMA(0, 0, At, B0); PG8_MMA(0, 1, At, B1); PG8_BAR; PG8_SCHED;
            PG8_LDA(At, 0, 1); PG8_STAGE(PG8_SB(0, 0), b2, voffB); PG8_STAGE(PG8_SB(0, 1), b2 + hstepB, voffB); PG8_STAGE(PG8_SA(0, 0), a2, voffA);
            PG8_WAIT_V(8); PG8_WAIT_L(0); PG8_BAR; PG8_MMA(1, 0, At, B0); PG8_MMA(1, 1, At, B1); PG8_BAR; PG8_SCHED;
            PG8_LDB(B0, 1, 0); PG8_LDB(B1, 1, 1); PG8_SCHED; PG8_LDA(At, 1, 0); PG8_STAGE(PG8_SA(0, 1), a2 + hstepA, voffA);
            PG8_WAIT_V(8); PG8_WAIT_L(0); PG8_BAR; PG8_MMA(0, 0, At, B0); PG8_MMA(0, 1, At, B1); PG8_BAR; PG8_SCHED;
            PG8_LDA(At, 1, 1); PG8_STAGE(PG8_SB(1, 0), b3, voffB); PG8_STAGE(PG8_SB(1, 1), b3 + hstepB, voffB); PG8_STAGE(PG8_SA(1, 0), a3, voffA);
            PG8_WAIT_V(8); PG8_WAIT_L(0); PG8_BAR; PG8_MMA(1, 0, At, B0); PG8_MMA(1, 1, At, B1); PG8_BAR; PG8_SCHED;
            } else {
            PG8_LDB(B0, 0, 0); PG8_SCHED; PG8_LDA(At, 0, 0); PG8_STAGE(PG8_SA(1, 1), a1 + hstepA, voffA);
            PG8_WAIT_L(8); PG8_BAR; PG8_WAIT_L(0); PG8_MMA(0, 0, At, B0); PG8_BAR; PG8_SCHED;
            PG8_LDB(B1, 0, 1); PG8_STAGE(PG8_SB(0, 0), b2, voffB);
            PG8_BAR; PG8_WAIT_L(0); PG8_MMA(0, 1, At, B1); PG8_BAR;
            PG8_LDA(At, 0, 1); PG8_STAGE(PG8_SA(0, 0), a2, voffA);
            PG8_BAR; PG8_WAIT_L(0); PG8_MMA(1, 0, At, B0); PG8_BAR; PG8_SCHED;
            PG8_STAGE(PG8_SB(0, 1), b2 + hstepB, voffB);
            PG8_WAIT_V(6); PG8_BAR; PG8_MMA(1, 1, At, B1); PG8_BAR;
            PG8_LDB(B0, 1, 0); PG8_SCHED; PG8_LDA(At, 1, 0); PG8_STAGE(PG8_SA(0, 1), a2 + hstepA, voffA);
            PG8_WAIT_L(8); PG8_BAR; PG8_WAIT_L(0); PG8_MMA(0, 0, At, B0); PG8_BAR; PG8_SCHED;
            PG8_LDB(B1, 1, 1); PG8_STAGE(PG8_SB(1, 0), b3, voffB);
            PG8_BAR; PG8_WAIT_L(0); PG8_MMA(0, 1, At, B1); PG8_BAR;
            PG8_LDA(At, 1, 1); PG8_STAGE(PG8_SA(1, 0), a3, voffA);
            PG8_BAR; PG8_WAIT_L(0); PG8_MMA(1, 0, At, B0); PG8_BAR; PG8_SCHED;
            PG8_STAGE(PG8_SB(1, 1), b3 + hstepB, voffB);
            PG8_WAIT_V(6); PG8_BAR; PG8_MMA(1, 1, At, B1); PG8_BAR;
            }
        }
        if constexpr (ALIGN_EPI) { if (wr == 0) PG8_BAR; }
        if constexpr (!Epi::AFTER_DRAIN) { E(acc, cur, wr, wc, fr, fq); S.done(cur); }
        if (!has_next) break;
#pragma unroll
        for (int a = 0; a < 2; ++a)
#pragma unroll
            for (int b = 0; b < 2; ++b)
#pragma unroll
                for (int m = 0; m < 4; ++m)
#pragma unroll
                    for (int n = 0; n < 2; ++n) acc[a][b][m][n] = (f32x4){0.f, 0.f, 0.f, 0.f};
        cur = nxt; cA = nA; cB = nB; ++ui;
        if constexpr (ALIGN_EPI) { if (wr == 1) PG8_BAR; }
    }
    PG8_WAIT_V(0);
    if constexpr (!ALIGN_EPI) { if (wr == 0) PG8_BAR; }
    PG8_BAR;
    if constexpr (Epi::AFTER_DRAIN) { E.fused(acc, cur, wr, wc, fr, fq, lds, wid, lane); S.done(cur); }
#undef PG8_AK
#undef PG8_SA
#undef PG8_SB
#undef PG8_STAGE
#undef PG8_LDA
#undef PG8_LDB
#undef PG8_MMA
#undef PG8_WAIT_V
#undef PG8_WAIT_L
#undef PG8_BAR
#undef PG8_SCHED
}
}

#define LAS __attribute__((address_space(3)))
typedef unsigned short bf16_t;
typedef short bf16x8 __attribute__((ext_vector_type(8)));
typedef short s16x4 __attribute__((ext_vector_type(4)));
typedef float f32x4 __attribute__((ext_vector_type(4)));
typedef float f32x2 __attribute__((ext_vector_type(2)));
typedef float f32x16 __attribute__((ext_vector_type(16)));
typedef unsigned u32x4 __attribute__((ext_vector_type(4)));
typedef unsigned u32x2 __attribute__((ext_vector_type(2)));

constexpr int BATCH = 4, SEQ = 8192, DM = 1024, M = BATCH * SEQ;
constexpr int DFF = 2816, NFF2 = 2 * DFF;
constexpr float EPS = 1e-6f;
constexpr float L2E = 1.4426950408889634f;
constexpr float C2F = 0.125f * L2E;
constexpr float C2M = 0.07216878364870322f * L2E;
constexpr size_t MiB = 1u << 20;
constexpr size_t WS_CTOT = 64 * 1024;
constexpr size_t WS_RSTD0 = 1 * MiB;
constexpr size_t WS_SSQ1 = WS_RSTD0 + 128 * 1024, WS_SSQ2 = WS_SSQ1 + 128 * 1024, WS_SSQ3 = WS_SSQ2 + 128 * 1024, WS_SSQQ = WS_SSQ3 + 128 * 1024, WS_SSQL = WS_SSQQ + 128 * 1024;
constexpr size_t WS_LOGF = 2 * MiB, WS_CUMT = 4 * MiB, WS_ROPE = 6 * MiB;
constexpr size_t WS_WQKV = 8 * MiB, WS_WFO = 14 * MiB, WS_WFI0 = 16 * MiB, WS_WFD0 = 27 * MiB;
constexpr size_t WS_LAT = 8 * MiB, WS_KR = 24 * MiB;
constexpr size_t WS_WFI1 = 33 * MiB, WS_WFD1 = 44 * MiB, WS_WDN = 50 * MiB, WS_WUQ = 53 * MiB, WS_WUKV = 58 * MiB, WS_WMO = 60 * MiB;
constexpr size_t WS_QM = 64 * MiB, WS_KN = 256 * MiB, WS_VM = 384 * MiB;
constexpr size_t WS_XB = 386 * MiB;
constexpr size_t WS_CQ = 256 * MiB;
constexpr size_t WS_Q0 = 64 * MiB, WS_K0 = 128 * MiB, WS_V0 = 192 * MiB;
constexpr size_t WS_G = 64 * MiB;
constexpr size_t WS_END = 512 * MiB;
constexpr int LDS_XCH = 131072, LDS_MISC = 131072 + 8192, LDS_BYTES = 147456;

__device__ __forceinline__ unsigned cvtpk(float lo, float hi) { typedef __bf16 bf2 __attribute__((ext_vector_type(2))); f32x2 v = {lo, hi}; bf2 b = __builtin_convertvector(v, bf2); return __builtin_bit_cast(unsigned, b); }
__device__ __forceinline__ float wave_sum(float v) {
#pragma unroll
    for (int o = 1; o < 64; o <<= 1) v += __shfl_xor(v, o);
    return v;
}
__device__ __forceinline__ void atomic_addf(float* p, float v) { (void)__hip_atomic_fetch_add(p, v, __ATOMIC_RELAXED, __HIP_MEMORY_SCOPE_AGENT); }
__device__ __forceinline__ int ropedim(int p) { return 4 * (p >> 3) + (p & 3) + 32 * ((p >> 2) & 1); }

__device__ __forceinline__ int srccol(int mode, int c0, int n) {
    if (mode == 0) return c0 + n;
    if (mode == 1) return ((n & 128) ? DFF : 0) + (n >> 8) * 128 + (n & 127);
    if (mode == 2) return c0 + ropedim(n);
    if (n < 2048) return (n >> 7) * 192 + (n & 127);
    const int m = n - 2048; return (m >> 6) * 192 + 128 + ropedim(m & 63);
}
__device__ __forceinline__ void tr_item(const float* __restrict__ W, int K, int N, bf16_t* WT, int row_off, const float* __restrict__ gain, int mode, int c0, int nblk, LAS float* scr, int item, int lane) {
    const int kb = item / nblk, nb = item % nblk, k0 = 64 * kb, n0 = 32 * nb;
    const int col = srccol(mode, c0, n0 + (lane & 31));
    float vals[32], gv[32];
#pragma unroll
    for (int i = 0; i < 32; ++i) { const int kk = 2 * i + (lane >> 5); vals[i] = W[(size_t)(k0 + kk) * N + col]; gv[i] = gain ? gain[k0 + kk] : 1.0f; }
#pragma unroll
    for (int i = 0; i < 32; ++i) { const int kk = 2 * i + (lane >> 5); scr[kk * 33 + (lane & 31)] = vals[i] * gv[i]; }
    asm volatile("s_waitcnt lgkmcnt(0)" ::: "memory");
    const int c = lane & 7;
#pragma unroll
    for (int j = 0; j < 4; ++j) { const int n = (lane >> 3) + 8 * j; const LAS float* s = scr + (8 * c) * 33 + n;
        u32x4 o; o.x = cvtpk(s[0 * 33], s[1 * 33]); o.y = cvtpk(s[2 * 33], s[3 * 33]); o.z = cvtpk(s[4 * 33], s[5 * 33]); o.w = cvtpk(s[6 * 33], s[7 * 33]);
        *(u32x4*)(WT + (size_t)(row_off + n0 + n) * K + k0 + 8 * c) = o; }
    asm volatile("s_waitcnt lgkmcnt(0)" ::: "memory");
}

struct P { const float *x, *fox_norm, *w_fox_in, *b_fox_f, *w_fox_out, *kv_in_norm, *w_dkv, *kv_norm, *w_uk, *w_uv, *mla_norm, *w_dq, *q_norm, *w_uq, *w_mla_out, *ffn_norm, *w_ffn_in, *ffn_conv_w, *ffn_conv_b, *w_ffn_out, *final_norm; float* out; unsigned char* ws; };

__device__ __forceinline__ void phase_prologue(const P& p, LAS unsigned char* lds, int gw, int NGW, int gtid, int NGT, int part) {
    const int tid = threadIdx.x, lane = tid & 63, wave = tid >> 6;
    unsigned char* ws = p.ws;
    LAS float* scr = (LAS float*)(lds + wave * 8704);
#define TRJOB(cnt, W, K, N, WT, roff, gain, mode, c0, nrows) { const int n_ = (K / 64) * ((nrows) / 32); if (r < n_) { tr_item(W, K, N, (bf16_t*)(ws + (WT)), roff, gain, mode, c0, (nrows) / 32, scr, r, lane); continue; } r -= n_; }
    if (part & 1) {
    constexpr int NITEMS = 16 * 96 + 16 * 32 + 2 * 16 * 176 + 2 * 44 * 32 + 16 * 24 + 16 * 8 + 16 * 2 + 12 * 96 + 4 * 64 * 2 + 32 * 32;
    for (int it = gw; it < NITEMS; it += NGW) {
        int r = it;
        TRJOB(0, p.w_fox_in, 1024, 3088, WS_WQKV, 0, p.fox_norm, 0, 0, 3072)
        TRJOB(0, p.w_fox_out, 1024, 1024, WS_WFO, 0, (const float*)nullptr, 0, 0, 1024)
        TRJOB(0, p.w_ffn_in, 1024, NFF2, WS_WFI0, 0, p.ffn_norm, 1, 0, NFF2)
        TRJOB(0, p.w_ffn_in + (size_t)1024 * NFF2, 1024, NFF2, WS_WFI1, 0, p.ffn_norm + 1024, 1, 0, NFF2)
        TRJOB(0, p.w_ffn_out, DFF, 1024, WS_WFD0, 0, (const float*)nullptr, 0, 0, 1024)
        TRJOB(0, p.w_ffn_out + (size_t)DFF * 1024, DFF, 1024, WS_WFD1, 0, (const float*)nullptr, 0, 0, 1024)
        TRJOB(0, p.w_dq, 1024, 768, WS_WDN, 0, p.mla_norm, 0, 0, 768)
        TRJOB(0, p.w_dkv, 1024, 320, WS_WDN, 768, p.kv_in_norm, 0, 0, 256)
        TRJOB(0, p.w_dkv, 1024, 320, WS_WDN, 1024, p.kv_in_norm, 2, 256, 64)
        TRJOB(0, p.w_uq, 768, 3072, WS_WUQ, 0, p.q_norm, 3, 0, 3072)
        TRJOB(0, p.w_uk, 256, 2048, WS_WUKV, 0, p.kv_norm, 0, 0, 2048)
        TRJOB(0, p.w_uv, 256, 2048, WS_WUKV, 2048, p.kv_norm, 0, 0, 2048)
        TRJOB(0, p.w_mla_out, 2048, 1024, WS_WMO, 0, (const float*)nullptr, 0, 0, 1024)
    }
#undef TRJOB
    { float* z = (float*)(ws + WS_SSQ1); for (int i = gtid; i < 5 * M; i += NGT) z[i] = 0.f; }
    { f32x2* rt = (f32x2*)(ws + WS_ROPE);
      for (int i = gtid; i < SEQ * 32; i += NGT) { const int pos = i >> 5, f = i & 31;
          const float inv = (float)exp2(-(double)f * (13.287712379549449 / 32.0));
          const float ang = (float)pos * inv;
          const double a = (double)ang; const double k = rint(a * 0.6366197723675814);
          double r = fma(-k, 1.5707963267948966, a); r = fma(-k, 6.123233995736766e-17, r);
          const double r2 = r * r;
          double sn = r2 * (1.0 / 6227020800.0) - (1.0 / 39916800.0); sn = sn * r2 + (1.0 / 362880.0); sn = sn * r2 - (1.0 / 5040.0); sn = sn * r2 + (1.0 / 120.0); sn = sn * r2 - (1.0 / 6.0); sn = sn * r2 * r + r;
          double cs = r2 * (-1.0 / 87178291200.0) + (1.0 / 479001600.0); cs = cs * r2 - (1.0 / 3628800.0); cs = cs * r2 + (1.0 / 40320.0); cs = cs * r2 - (1.0 / 720.0); cs = cs * r2 + (1.0 / 24.0); cs = cs * r2 - 0.5; cs = cs * r2 + 1.0;
          const int q = ((int)k) & 3; const double c = (q == 0) ? cs : (q == 1) ? -sn : (q == 2) ? -cs : sn; const double s = (q == 0) ? sn : (q == 1) ? cs : (q == 2) ? -sn : -cs;
          rt[i] = (f32x2){(float)c, (float)s}; } }
    }
    if (!(part & 2)) return;
    __syncthreads();
    LAS float* wft = (LAS float*)lds;
    { float wv[32], gv2[32];
#pragma unroll
      for (int it = 0; it < 32; ++it) { const int i = tid + 512 * it, k = i >> 4, h = i & 15; wv[it] = p.w_fox_in[(size_t)k * 3088 + 3072 + h]; gv2[it] = p.fox_norm[k]; }
#pragma unroll
      for (int it = 0; it < 32; ++it) { const int i = tid + 512 * it, k = i >> 4, h = i & 15; wft[h * 1024 + k] = wv[it] * gv2[it]; } }
    __syncthreads();
    { bf16_t* XB = (bf16_t*)(ws + WS_XB); float* rstd0 = (float*)(ws + WS_RSTD0); float* logf_ = (float*)(ws + WS_LOGF);
      const float bfh = p.b_fox_f[(lane >> 2) & 15];
      f32x4 v[4];
      if (gw < M) { const f32x4* xr0 = (const f32x4*)(p.x + (size_t)gw * DM) + lane;
#pragma unroll
          for (int j = 0; j < 4; ++j) v[j] = xr0[64 * j]; }
      for (int m = gw; m < M; m += NGW) {
          asm volatile("" ::: "memory");
          f32x4 nv[4];
          { const int mn = (m + NGW < M) ? m + NGW : m; const f32x4* xrn = (const f32x4*)(p.x + (size_t)mn * DM) + lane;
#pragma unroll
            for (int j = 0; j < 4; ++j) nv[j] = xrn[64 * j]; }
          float s = 0.f;
#pragma unroll
          for (int j = 0; j < 4; ++j) s += (v[j].x * v[j].x + v[j].y * v[j].y) + (v[j].z * v[j].z + v[j].w * v[j].w);
          const float rstd = 1.0f / sqrtf(wave_sum(s) * (1.0f / DM) + EPS);
          unsigned long long* o8 = (unsigned long long*)(XB + (size_t)m * DM) + lane;
#pragma unroll
          for (int j = 0; j < 4; ++j) o8[64 * j] = (unsigned long long)cvtpk(v[j].x, v[j].y) | ((unsigned long long)cvtpk(v[j].z, v[j].w) << 32);
          float a[16];
#pragma unroll
          for (int h = 0; h < 16; ++h) { float t = 0.f;
#pragma unroll
              for (int j = 0; j < 4; ++j) { const f32x4 w = *(const LAS f32x4*)(wft + h * 1024 + 256 * j + 4 * lane); t += (v[j].x * w.x + v[j].y * w.y) + (v[j].z * w.z + v[j].w * w.w); }
              a[h] = t; }
#pragma unroll
          for (int k = 0; k < 8; ++k) { const float keep = (lane & 32) ? a[k + 8] : a[k], send = (lane & 32) ? a[k] : a[k + 8]; a[k] = keep + __shfl_xor(send, 32); }
#pragma unroll
          for (int k = 0; k < 4; ++k) { const float keep = (lane & 16) ? a[k + 4] : a[k], send = (lane & 16) ? a[k] : a[k + 4]; a[k] = keep + __shfl_xor(send, 16); }
#pragma unroll
          for (int k = 0; k < 2; ++k) { const float keep = (lane & 8) ? a[k + 2] : a[k], send = (lane & 8) ? a[k] : a[k + 2]; a[k] = keep + __shfl_xor(send, 8); }
          { const float keep = (lane & 4) ? a[1] : a[0], send = (lane & 4) ? a[0] : a[1]; a[0] = keep + __shfl_xor(send, 4); }
          a[0] += __shfl_xor(a[0], 2); a[0] += __shfl_xor(a[0], 1);
          const float z = a[0] * rstd + bfh;
          const float ls = fminf(z, 0.f) - log1pf(__expf(-fabsf(z)));
          if (lane == 0) rstd0[m] = rstd;
          if ((lane & 3) == 0) logf_[(size_t)m * 16 + (lane >> 2)] = ls;
#pragma unroll
          for (int j = 0; j < 4; ++j) v[j] = nv[j];
      } }
}

__device__ __forceinline__ void chunk_scan(const P& p, LAS unsigned char* lds, int c) {
    const int tid = threadIdx.x, h = tid & 15, seg = tid >> 4;
    const float* lf = (const float*)(p.ws + WS_LOGF) + ((size_t)c * 256 + seg * 8) * 16 + h;
    float s[8]; float run = 0.f;
#pragma unroll
    for (int i = 0; i < 8; ++i) { run += lf[i * 16]; s[i] = run; }
    LAS float* tot = (LAS float*)(lds + LDS_MISC);
    tot[seg * 16 + h] = run;
    __syncthreads();
    float off = 0.f;
    for (int g = 0; g < seg; ++g) off += tot[g * 16 + h];
    const int b = c >> 5, cc = c & 31;
    float* ct = (float*)(p.ws + WS_CUMT) + ((size_t)(b * 16 + h)) * SEQ + cc * 256 + seg * 8;
#pragma unroll
    for (int i = 0; i < 8; ++i) ct[i] = (off + s[i]) * L2E;
    if (seg == 31) ((float*)(p.ws + WS_CTOT))[c * 16 + h] = (off + run) * L2E;
    __syncthreads();
}

__device__ __forceinline__ void phase_final(const P& p, int gw, int NGW) {
    const int lane = threadIdx.x & 63;
    f32x4 g[4];
#pragma unroll
    for (int j = 0; j < 4; ++j) g[j] = ((const f32x4*)p.final_norm)[64 * j + lane];
    f32x4 v[4];
    if (gw < M) { const f32x4* x0 = (const f32x4*)(p.out + (size_t)gw * DM) + lane;
#pragma unroll
        for (int j = 0; j < 4; ++j) v[j] = x0[64 * j]; }
    for (int m = gw; m < M; m += NGW) {
        f32x4* xr = (f32x4*)(p.out + (size_t)m * DM) + lane;
        f32x4 nv[4];
        { const int mn = (m + NGW < M) ? m + NGW : m; const f32x4* xn = (const f32x4*)(p.out + (size_t)mn * DM) + lane;
#pragma unroll
          for (int j = 0; j < 4; ++j) nv[j] = xn[64 * j]; }
        float s = 0.f;
#pragma unroll
        for (int j = 0; j < 4; ++j) s += (v[j].x * v[j].x + v[j].y * v[j].y) + (v[j].z * v[j].z + v[j].w * v[j].w);
        const float rstd = 1.0f / sqrtf(wave_sum(s) * (1.0f / DM) + EPS);
#pragma unroll
        for (int j = 0; j < 4; ++j) xr[64 * j] = v[j] * rstd * g[j];
#pragma unroll
        for (int j = 0; j < 4; ++j) v[j] = nv[j];
    }
}

namespace epi {
using pg8::Unit; using pg8::BM; using pg8::HALF;

struct RowScaleSplit {
    static constexpr bool PERM = true, AFTER_DRAIN = false;
    bf16_t* O; int ldc; int split_cols; size_t split_stride; float scale0; const float* rsrc; float invn; int direct;
    __device__ __forceinline__ void operator()(const f32x4 (&acc)[2][2][4][2], const Unit& u, int wr, int wc, int fr, int fq) const {
        const int row0 = u.pm * BM + wr * 64 + fr; int colt = u.pn * BM; bf16_t* base = O;
        const int t = colt / split_cols; base += (size_t)t * split_stride; colt -= t * split_cols; const float sc = (t == 0) ? scale0 : 1.f;
        const int col0 = colt + wc * 32 + 8 * fq;
        float rsv[2][4];
#pragma unroll
        for (int ai = 0; ai < 2; ++ai)
#pragma unroll
            for (int m = 0; m < 4; ++m) rsv[ai][m] = rsrc[row0 + ai * HALF + m * 16];
#pragma unroll
        for (int ai = 0; ai < 2; ++ai)
#pragma unroll
            for (int m = 0; m < 4; ++m) { const int row = row0 + ai * HALF + m * 16; float rs = rsv[ai][m]; if (!direct) rs = 1.0f / sqrtf(rs * invn + EPS); rs *= sc;
                bf16_t* rowp = base + (size_t)row * ldc + col0;
#pragma unroll
                for (int bj = 0; bj < 2; ++bj) { const f32x4 v0 = acc[ai][bj][m][0] * rs, v1 = acc[ai][bj][m][1] * rs;
                    u32x4 w; w.x = cvtpk(v0[0], v0[1]); w.y = cvtpk(v0[2], v0[3]); w.z = cvtpk(v1[0], v1[1]); w.w = cvtpk(v1[2], v1[3]);
                    *(u32x4*)(rowp + bj * HALF) = w; } }
    }
};

struct Residual {
    static constexpr bool PERM = false, AFTER_DRAIN = false;
    const float* xold; float* out; bf16_t* xb; float* ssq;
    __device__ __forceinline__ void operator()(const f32x4 (&acc)[2][2][4][2], const Unit& u, int wr, int wc, int fr, int fq) const {
        const int col0 = u.pn * BM + wc * 32 + 4 * fq;
#pragma unroll
        for (int ai = 0; ai < 2; ++ai) {
            f32x4 xo[4][2][2];
#pragma unroll
            for (int m = 0; m < 4; ++m)
#pragma unroll
                for (int bj = 0; bj < 2; ++bj)
#pragma unroll
                    for (int n = 0; n < 2; ++n) xo[m][bj][n] = *(const f32x4*)(xold + (size_t)(u.pm * BM + ai * HALF + wr * 64 + m * 16 + fr) * DM + col0 + bj * HALF + n * 16);
#pragma unroll
            for (int m = 0; m < 4; ++m) { const int row = u.pm * BM + ai * HALF + wr * 64 + m * 16 + fr; const size_t off = (size_t)row * DM + col0; float ss = 0.f;
#pragma unroll
                for (int bj = 0; bj < 2; ++bj)
#pragma unroll
                    for (int n = 0; n < 2; ++n) { const size_t o = off + bj * HALF + n * 16; const f32x4 v = xo[m][bj][n] + acc[ai][bj][m][n];
                        *(f32x4*)(out + o) = v; ss += (v[0] * v[0] + v[1] * v[1]) + (v[2] * v[2] + v[3] * v[3]);
                        if (xb) { u32x2 w; w.x = cvtpk(v[0], v[1]); w.y = cvtpk(v[2], v[3]); *(u32x2*)(xb + o) = w; } }
                if (ssq) { ss += __shfl_xor(ss, 16); ss += __shfl_xor(ss, 32); if (fq == 0) atomic_addf(ssq + row, ss); } }
        }
    }
};

struct MlaDown {
    static constexpr bool PERM = true, AFTER_DRAIN = false;
    const float* ssq2; bf16_t* CQ; bf16_t* LAT; bf16_t* KR; float* ssqq; float* ssql; const f32x4* rope;
    __device__ __forceinline__ void operator()(const f32x4 (&acc)[2][2][4][2], const Unit& u, int wr, int wc, int fr, int fq) const {
        const int pn = u.pn;
        if (pn == 4 && wc >= 2) return;
        float rsv[2][4];
#pragma unroll
        for (int ai = 0; ai < 2; ++ai)
#pragma unroll
            for (int m = 0; m < 4; ++m) rsv[ai][m] = ssq2[u.pm * BM + ai * HALF + wr * 64 + m * 16 + fr];
#pragma unroll
        for (int ai = 0; ai < 2; ++ai) {
            f32x4 rpv[4][2];
            if (pn == 4) {
#pragma unroll
                for (int m = 0; m < 4; ++m) { const int row = u.pm * BM + ai * HALF + wr * 64 + m * 16 + fr; const int pos = row & (SEQ - 1); const f32x4* rp = rope + ((size_t)pos * 32 + 16 * wc + 4 * fq) / 2; rpv[m][0] = rp[0]; rpv[m][1] = rp[1]; } }
#pragma unroll
            for (int m = 0; m < 4; ++m) { const int row = u.pm * BM + ai * HALF + wr * 64 + m * 16 + fr; const float rs = 1.0f / sqrtf(rsv[ai][m] * (1.0f / DM) + EPS);
                if (pn < 4) { bf16_t* rowp = (pn < 3) ? CQ + (size_t)row * 768 + pn * 256 + wc * 32 + 8 * fq : LAT + (size_t)row * 256 + wc * 32 + 8 * fq; float ss = 0.f;
#pragma unroll
                    for (int bj = 0; bj < 2; ++bj) { const f32x4 v0 = acc[ai][bj][m][0] * rs, v1 = acc[ai][bj][m][1] * rs;
                        ss += (v0[0] * v0[0] + v0[1] * v0[1]) + (v0[2] * v0[2] + v0[3] * v0[3]) + (v1[0] * v1[0] + v1[1] * v1[1]) + (v1[2] * v1[2] + v1[3] * v1[3]);
                        u32x4 w; w.x = cvtpk(v0[0], v0[1]); w.y = cvtpk(v0[2], v0[3]); w.z = cvtpk(v1[0], v1[1]); w.w = cvtpk(v1[2], v1[3]);
                        *(u32x4*)(rowp + bj * HALF) = w; }
                    ss += __shfl_xor(ss, 16); ss += __shfl_xor(ss, 32); if (fq == 0) atomic_addf((pn < 3 ? ssqq : ssql) + row, ss);
                } else { const f32x4 cs0 = rpv[m][0], cs1 = rpv[m][1];
                    const f32x4 x1 = acc[ai][0][m][0] * rs, x2 = acc[ai][0][m][1] * rs;
                    const float c[4] = {cs0[0], cs0[2], cs1[0], cs1[2]}, s[4] = {cs0[1], cs0[3], cs1[1], cs1[3]};
                    float o1[4], o2[4];
#pragma unroll
                    for (int i = 0; i < 4; ++i) { o1[i] = x1[i] * c[i] - x2[i] * s[i]; o2[i] = x1[i] * s[i] + x2[i] * c[i]; }
                    u32x4 w; w.x = cvtpk(o1[0], o1[1]); w.y = cvtpk(o1[2], o1[3]); w.z = cvtpk(o2[0], o2[1]); w.w = cvtpk(o2[2], o2[3]);
                    *(u32x4*)(KR + (size_t)row * 64 + 32 * wc + 8 * fq) = w; } }
        }
    }
};

struct MlaUq {
    static constexpr bool PERM = true, AFTER_DRAIN = false;
    const float* ssqq; bf16_t* QM; const f32x4* rope;
    __device__ __forceinline__ void operator()(const f32x4 (&acc)[2][2][4][2], const Unit& u, int wr, int wc, int fr, int fq) const {
        const int pn = u.pn;
        float rsv[2][4];
#pragma unroll
        for (int ai = 0; ai < 2; ++ai)
#pragma unroll
            for (int m = 0; m < 4; ++m) rsv[ai][m] = ssqq[u.pm * BM + ai * HALF + wr * 64 + m * 16 + fr];
#pragma unroll
        for (int ai = 0; ai < 2; ++ai) {
            f32x4 rpv[4][2][2];
            if (pn >= 8) {
#pragma unroll
                for (int m = 0; m < 4; ++m)
#pragma unroll
                    for (int bj = 0; bj < 2; ++bj) { const int row = u.pm * BM + ai * HALF + wr * 64 + m * 16 + fr; const int n2 = (pn - 8) * 256 + bj * 128 + wc * 32 + 8 * fq; const int p0 = n2 & 63; const int pos = row & (SEQ - 1);
                        const f32x4* rp = rope + ((size_t)pos * 32 + 4 * (p0 >> 3)) / 2; rpv[m][bj][0] = rp[0]; rpv[m][bj][1] = rp[1]; } }
#pragma unroll
            for (int m = 0; m < 4; ++m) { const int row = u.pm * BM + ai * HALF + wr * 64 + m * 16 + fr; const float rs = C2M / sqrtf(rsv[ai][m] * (1.0f / 768.0f) + EPS);
                bf16_t* rowp = QM + (size_t)row * 3072;
#pragma unroll
                for (int bj = 0; bj < 2; ++bj) { const f32x4 x1 = acc[ai][bj][m][0] * rs, x2 = acc[ai][bj][m][1] * rs; u32x4 w; int dcol;
                    if (pn < 8) { const int n1 = pn * 256 + bj * 128 + wc * 32 + 8 * fq; dcol = (n1 >> 7) * 192 + (n1 & 127);
                        w.x = cvtpk(x1[0], x1[1]); w.y = cvtpk(x1[2], x1[3]); w.z = cvtpk(x2[0], x2[1]); w.w = cvtpk(x2[2], x2[3]);
                    } else { const int n2 = (pn - 8) * 256 + bj * 128 + wc * 32 + 8 * fq; const int hh = n2 >> 6, p0 = n2 & 63; dcol = hh * 192 + 128 + p0;
                        const f32x4 cs0 = rpv[m][bj][0], cs1 = rpv[m][bj][1];
                        const float c[4] = {cs0[0], cs0[2], cs1[0], cs1[2]}, s[4] = {cs0[1], cs0[3], cs1[1], cs1[3]};
                        float o1[4], o2[4];
#pragma unroll
                        for (int i = 0; i < 4; ++i) { o1[i] = x1[i] * c[i] - x2[i] * s[i]; o2[i] = x1[i] * s[i] + x2[i] * c[i]; }
                        w.x = cvtpk(o1[0], o1[1]); w.y = cvtpk(o1[2], o1[3]); w.z = cvtpk(o2[0], o2[1]); w.w = cvtpk(o2[2], o2[3]); }
                    *(u32x4*)(rowp + dcol) = w; } }
        }
    }
};

__device__ __forceinline__ float dpp_shr1(float v) { return __builtin_bit_cast(float, __builtin_amdgcn_update_dpp(0, __builtin_bit_cast(int, v), 0x111, 0xf, 0xf, true)); }
__device__ __forceinline__ float dpp_shr2(float v) { return __builtin_bit_cast(float, __builtin_amdgcn_update_dpp(0, __builtin_bit_cast(int, v), 0x112, 0xf, 0xf, true)); }
__device__ __forceinline__ float dpp_shl15(float v) { return __builtin_bit_cast(float, __builtin_amdgcn_update_dpp(0, __builtin_bit_cast(int, v), 0x10f, 0xf, 0xf, true)); }
__device__ __forceinline__ float dpp_shl14(float v) { return __builtin_bit_cast(float, __builtin_amdgcn_update_dpp(0, __builtin_bit_cast(int, v), 0x10e, 0xf, 0xf, true)); }
struct ConvGate {
    static constexpr bool PERM = true, AFTER_DRAIN = false;
    bf16_t* G; const float* ssq; const float* cw; const float* cb; LAS f32x4* X;
    __device__ __forceinline__ void operator()(f32x4 (&acc)[2][2][4][2], const Unit& u, int wr, int wc, int fr, int fq) const {
        const int b = u.pm / 33, bk = u.pm - 33 * b; const int tb = 254 * bk - 2;
#pragma unroll
        for (int ai = 0; ai < 2; ++ai)
#pragma unroll
            for (int m = 0; m < 4; ++m) { const int t = tb + 128 * ai + 64 * wr + 16 * m + fr; float rs = 0.f; if (t >= 0 && t < SEQ) rs = 1.0f / sqrtf(ssq[b * SEQ + t] * (1.0f / DM) + EPS);
#pragma unroll
                for (int bj = 0; bj < 2; ++bj)
#pragma unroll
                    for (int n = 0; n < 2; ++n) acc[ai][bj][m][n] *= rs; }
        LAS f32x4* PL = X + 512 + 164 + ((wr * 4 + wc) * 4 + fq) * 8;
        if (fr == 0) { const int col1 = 128 * u.pn + 32 * wc + 8 * fq + 4;
            const f32x4 q0 = *(const f32x4*)(cw + col1), q1 = *(const f32x4*)(cw + NFF2 + col1), q2 = *(const f32x4*)(cw + 2 * NFF2 + col1), q3 = *(const f32x4*)(cb + col1);
            const f32x4 q4 = *(const f32x4*)(cw + DFF + col1), q5 = *(const f32x4*)(cw + NFF2 + DFF + col1), q6 = *(const f32x4*)(cw + 2 * NFF2 + DFF + col1), q7 = *(const f32x4*)(cb + DFF + col1);
            PL[0] = q0; PL[1] = q1; PL[2] = q2; PL[3] = q3; PL[4] = q4; PL[5] = q5; PL[6] = q6; PL[7] = q7; }
        if (fr >= 14) {
#pragma unroll
            for (int ai = 0; ai < 2; ++ai)
#pragma unroll
                for (int bj = 0; bj < 2; ++bj)
#pragma unroll
                    for (int n = 0; n < 2; ++n) X[((((((2 * ai + wr) * 4 + wc) * 2 + bj) * 2 + n) * 4 + fq) * 2) + (fr - 14)] = acc[ai][bj][3][n]; }
        asm volatile("s_waitcnt lgkmcnt(0)\n\ts_barrier" ::: "memory");
#pragma unroll
        for (int n = 0; n < 2; ++n) {
            const int col = 128 * u.pn + 32 * wc + 8 * fq + 4 * n;
            f32x4 w0g, w1g, w2g, bg, w0v, w1v, w2v, bv;
            if (n == 0) { w0g = *(const f32x4*)(cw + col); w1g = *(const f32x4*)(cw + NFF2 + col); w2g = *(const f32x4*)(cw + 2 * NFF2 + col); bg = *(const f32x4*)(cb + col);
                w0v = *(const f32x4*)(cw + DFF + col); w1v = *(const f32x4*)(cw + NFF2 + DFF + col); w2v = *(const f32x4*)(cw + 2 * NFF2 + DFF + col); bv = *(const f32x4*)(cb + DFF + col); }
            else { w0g = PL[0]; w1g = PL[1]; w2g = PL[2]; bg = PL[3]; w0v = PL[4]; w1v = PL[5]; w2v = PL[6]; bv = PL[7]; }
#pragma unroll
            for (int ai = 0; ai < 2; ++ai) { const int span = 2 * ai + wr;
                f32x4 h1g = {0.f, 0.f, 0.f, 0.f}, h2g = h1g, h1v = h1g, h2v = h1g;
                if (span > 0) { const int xb0 = (((((span - 1) * 4 + wc) * 2 + 0) * 2 + n) * 4 + fq) * 2, xb1 = (((((span - 1) * 4 + wc) * 2 + 1) * 2 + n) * 4 + fq) * 2;
                    const f32x4 ga = X[xb0], gb = X[xb0 + 1], va = X[xb1], vb = X[xb1 + 1];
                    if (fr == 0) { h1g = gb; h2g = ga; h1v = vb; h2v = va; } else if (fr == 1) { h2g = gb; h2v = vb; } }
#pragma unroll
                for (int m = 0; m < 4; ++m) { const f32x4 ag = acc[ai][0][m][n], av = acc[ai][1][m][n]; f32x4 p1g, p2g, p1v, p2v;
#pragma unroll
                    for (int i = 0; i < 4; ++i) {
                        if (m == 0) { p1g[i] = dpp_shr1(ag[i]) + h1g[i]; p2g[i] = dpp_shr2(ag[i]) + h2g[i]; p1v[i] = dpp_shr1(av[i]) + h1v[i]; p2v[i] = dpp_shr2(av[i]) + h2v[i]; }
                        else { const int mm = (m == 0) ? 0 : m - 1;
                            p1g[i] = dpp_shr1(ag[i]) + dpp_shl15(acc[ai][0][mm][n][i]); p2g[i] = dpp_shr2(ag[i]) + dpp_shl14(acc[ai][0][mm][n][i]);
                            p1v[i] = dpp_shr1(av[i]) + dpp_shl15(acc[ai][1][mm][n][i]); p2v[i] = dpp_shr2(av[i]) + dpp_shl14(acc[ai][1][mm][n][i]); } }
                    const f32x4 cg_ = bg + w0g * p2g + w1g * p1g + w2g * ag, cv_ = bv + w0v * p2v + w1v * p1v + w2v * av;
                    float o[4];
#pragma unroll
                    for (int i = 0; i < 4; ++i) o[i] = cg_[i] * __builtin_amdgcn_rcpf(1.0f + __expf(-cg_[i])) * cv_[i];
                    const int ir = 128 * ai + 64 * wr + 16 * m + fr, t = tb + ir;
                    if (ir >= 2 && t < SEQ) { u32x2 w; w.x = cvtpk(o[0], o[1]); w.y = cvtpk(o[2], o[3]); *(u32x2*)(G + (size_t)(b * SEQ + t) * DFF + col) = w; } } }
        }
    }
};
}

struct ConvOrder {
    int G, c;
    __device__ __forceinline__ bool next(int i, pg8::Unit& u) const {
        const int L = i * G + c; if (L >= 4 * 33 * 22) return false;
        const int ru = L / 22; u.pn = L - 22 * ru; u.pm = ru; const int b = ru / 33, bk = ru - 33 * b; u.ar = b * SEQ + 254 * bk - 2; return true; }
    __device__ __forceinline__ void a_ready(const pg8::Unit&) const {}
    __device__ __forceinline__ void done(const pg8::Unit&) const {}
};

namespace att {
template <int DQK, int DV, bool FOX> struct Cfg {
    static constexpr int KRB = DQK * 2, VRB = DV * 2, NKC = DQK / 8, NVC = DV / 8;
    static constexpr int TR = FOX ? 128 : 64, SUBS = TR / 64;
    static constexpr int KT = TR * KRB, VT = TR * VRB, BT = FOX ? 8 * 4 * TR : 0, BUF = KT + VT + BT;
    static constexpr int DIST = 1, NBUF = 3;
    static constexpr int KPW = TR * NKC / 512, VPW = TR * NVC / 512, NDMA = KPW + VPW + (FOX ? SUBS : 0);
    static constexpr int TOTAL = NBUF * BUF;
};
__device__ __forceinline__ s16x4 vtr(const LAS unsigned char* p) { typedef short v4i16_t __attribute__((ext_vector_type(4))); return __builtin_bit_cast(s16x4, __builtin_amdgcn_ds_read_tr16_b64_v4i16((LAS v4i16_t*)p)); }
#define ATT_WAIT(N) asm volatile("s_waitcnt vmcnt(" #N ") lgkmcnt(0)\n\ts_barrier" ::: "memory")

template <int DQK, int DV, bool FOX>
__device__ __forceinline__ void attn_unit(LAS unsigned char* lds, int b, int h, int qb,
        const bf16_t* Q, int qpitch, const bf16_t* __restrict__ Kn, int kpitch, int khw, const bf16_t* __restrict__ Kr, const bf16_t* __restrict__ V, int vpitch,
        bf16_t* O, int opitch, int ohw, const float* __restrict__ cumT, const float* __restrict__ ctot, const bf16_t* wsb, bool dry) {
    using C = Cfg<DQK, DV, FOX>;
    constexpr int NKS = DQK / 16, NDB = DV / 32;
    const int tid = threadIdx.x, lane = tid & 63, wid = __builtin_amdgcn_readfirstlane(tid >> 6), r32 = lane & 31, hi = lane >> 5;
    const long rowbase = (long)b * SEQ; const int q0 = qb * 256;
    const int NT = (q0 + 256) / 64;
    const int jdiag = (q0 + 32 * wid) >> 6;
    unsigned koff[C::KPW], kstp[C::KPW], voff[C::VPW];
#pragma unroll
    for (int c = 0; c < C::KPW; ++c) { const int p = 64 * (wid + 8 * c) + lane, row = p / C::NKC, pos = p - row * C::NKC, ch = (pos & ~7) | ((pos & 7) ^ ((row >> 1) & 7));
        if (FOX || ch < 16) { koff[c] = (unsigned)((Kn - wsb) + (rowbase + row) * kpitch + h * khw + ch * 8); kstp[c] = (unsigned)C::TR * kpitch; }
        else { koff[c] = (unsigned)((Kr - wsb) + (rowbase + row) * 64 + (ch - 16) * 8); kstp[c] = (unsigned)C::TR * 64u; } }
#pragma unroll
    for (int c = 0; c < C::VPW; ++c) { const int p = 64 * (wid + 8 * c) + lane, row = p / C::NVC, pos = p - row * C::NVC;
        const int f = (DV == 128) ? (((row & 3) << 2) | ((row >> 2) & 3)) : (4 * ((row >> 1) & 1)); const int ch = pos ^ f;
        voff[c] = (unsigned)((V - wsb) + (rowbase + row) * vpitch + h * DV + ch * 8); }
    const float* csrc = FOX ? cumT + ((size_t)(b * 16 + h)) * SEQ + lane : nullptr;
#define ATT_ISSUE(j, bufo) do { \
        _Pragma("unroll") for (int c = 0; c < C::KPW; ++c) __builtin_amdgcn_global_load_lds((const unsigned*)(wsb + (koff[c] + (unsigned)(j) * kstp[c])), (LAS unsigned*)(lds + (bufo) + (wid + 8 * c) * 1024), 16, 0, 0); \
        _Pragma("unroll") for (int c = 0; c < C::VPW; ++c) __builtin_amdgcn_global_load_lds((const unsigned*)(wsb + (voff[c] + (unsigned)(j) * (unsigned)C::TR * (unsigned)vpitch)), (LAS unsigned*)(lds + (bufo) + C::KT + (wid + 8 * c) * 1024), 16, 0, 0); \
        if (FOX) { _Pragma("unroll") for (int c2 = 0; c2 < C::SUBS; ++c2) __builtin_amdgcn_global_load_lds((const unsigned*)(csrc + (j) * C::TR + 64 * c2), (LAS unsigned*)(lds + (bufo) + C::KT + C::VT + wid * (4 * C::TR) + 256 * c2), 4, 0, 0); } } while (0)
    LAS float* pre = (LAS float*)(lds + C::TOTAL);
    bf16x8 qr[NKS];
    { const bf16_t* qp = Q + (rowbase + q0 + 32 * wid + r32) * qpitch + h * DQK + 8 * hi;
#pragma unroll
      for (int ks = 0; ks < NKS; ++ks) qr[ks] = *(const bf16x8*)(qp + 16 * ks); }
    float ct = 0.f;
    if (FOX) { if (wid == 0) { const float v0 = (lane < 32) ? ctot[(b * 32 + (lane & 31)) * 16 + h] : 0.f; float s = v0;
#pragma unroll
            for (int d = 1; d < 32; d <<= 1) { const float t = __shfl_up(s, d); if (lane >= d) s += t; }
            if (lane < 32) pre[lane] = s - v0; }
        ct = cumT[((size_t)(b * 16 + h)) * SEQ + q0 + 32 * wid + r32]; }
    ATT_ISSUE(0, 0);
    ATT_WAIT(0);
#pragma unroll
    for (int ks = 0; ks < NKS; ++ks) asm volatile("" : "+v"(qr[ks]));
    asm volatile("" : "+v"(ct));
    if (FOX) ct += pre[qb];
    float m_run = 0.f, l_run = 0.f;
    f32x16 osum;
#pragma unroll
    for (int r = 0; r < 16; ++r) osum[r] = 0.f;
    const short one_ = (r32 == 0) ? (short)0x3F80 : (short)0; const bf16x8 vones = {one_, one_, one_, one_, one_, one_, one_, one_};
    f32x16 o[NDB];
#pragma unroll
    for (int d = 0; d < NDB; ++d)
#pragma unroll
        for (int r = 0; r < 16; ++r) o[d][r] = 0.f;
    const int sw = (r32 >> 1) & 7;
    int ka[4];
#pragma unroll
    for (int k = 0; k < 4; ++k) ka[k] = r32 * C::KRB + 16 * ((2 * k + hi) ^ sw);
    const int q4 = (lane >> 2) & 3, e2 = (lane >> 4) & 1, pp = lane & 3;
    int vlo[2], vdo[NDB];
    if (DV == 128) {
#pragma unroll
        for (int part = 0; part < 2; ++part) vlo[part] = (4 * hi + q4) * C::VRB + 16 * ((2 * e2 + (pp >> 1)) ^ ((hi + 2 * part) & 3)) + 8 * (pp & 1) + 8 * part * C::VRB;
#pragma unroll
        for (int d = 0; d < NDB; ++d) vdo[d] = 64 * (d ^ q4);
    } else {
#pragma unroll
        for (int part = 0; part < 2; ++part) vlo[part] = (4 * hi + q4) * C::VRB + 16 * (2 * e2 + (pp >> 1)) + 8 * (pp & 1) + 8 * part * C::VRB;
#pragma unroll
        for (int d = 0; d < NDB; ++d) vdo[d] = 64 * (d ^ (q4 >> 1));
    }
    const bool odd = wid >= 4;
    f32x16 p0, p1;
#define ATT_SCORES(jj, boff, sub) do { \
        const LAS unsigned char* Kb = lds + (boff) + (sub) * 64 * C::KRB; \
        if (FOX) { const LAS float* bb = (const LAS float*)(lds + (boff) + C::KT + C::VT) + 64 * (sub) + 4 * hi; const float cm = ct - m_run - pre[(jj) >> 2]; \
            _Pragma("unroll") for (int g4 = 0; g4 < 4; ++g4) { const f32x4 c0 = *(const LAS f32x4*)(bb + 8 * g4), c1 = *(const LAS f32x4*)(bb + 32 + 8 * g4); \
                _Pragma("unroll") for (int i = 0; i < 4; ++i) { p0[4 * g4 + i] = cm - c0[i]; p1[4 * g4 + i] = cm - c1[i]; } } \
        } else { _Pragma("unroll") for (int r = 0; r < 16; ++r) { p0[r] = 0.f; p1[r] = 0.f; } } \
        _Pragma("unroll") for (int ks = 0; ks < NKS; ++ks) { const bf16x8 k0 = *(const LAS bf16x8*)(Kb + ka[ks & 3] + 128 * (ks >> 2)); p0 = __builtin_amdgcn_mfma_f32_32x32x16_bf16(k0, qr[ks], p0, 0, 0, 0); } \
        _Pragma("unroll") for (int ks = 0; ks < NKS; ++ks) { const bf16x8 k1 = *(const LAS bf16x8*)(Kb + ka[ks & 3] + 32 * C::KRB + 128 * (ks >> 2)); p1 = __builtin_amdgcn_mfma_f32_32x32x16_bf16(k1, qr[ks], p1, 0, 0, 0); } \
        __builtin_amdgcn_sched_group_barrier(0x100, FOX ? 12 : 4, 0); \
        _Pragma("unroll") for (int i_ = 0; i_ < 2 * NKS - 4; ++i_) { __builtin_amdgcn_sched_group_barrier(0x008, 1, 0); __builtin_amdgcn_sched_group_barrier(0x100, 1, 0); } \
        __builtin_amdgcn_sched_group_barrier(0x008, 4, 0); \
        if (FOX && (jj) == jdiag) { const int qa = q0 + 32 * wid + r32, kvb = 64 * (jj) + 4 * hi; \
            _Pragma("unroll") for (int r = 0; r < 16; ++r) { const int kv = kvb + (r & 3) + 8 * (r >> 2); if (kv > qa) p0[r] = -1e30f; if (kv + 32 > qa) p1[r] = -1e30f; } } \
    } while (0)
#define ATT_HALF(P, PO, HALF, HAVE_OTHER, jj, Vb) do { \
        float mx = __builtin_fmaxf(P[0], P[1]); \
        _Pragma("unroll") for (int r = 2; r < 16; r += 2) mx = __builtin_fmaxf(__builtin_fmaxf(mx, P[r]), P[r + 1]); \
        { auto rr_ = __builtin_amdgcn_permlane32_swap(__float_as_uint(mx), __float_as_uint(mx), false, false); mx = __builtin_fmaxf(__uint_as_float(rr_[0]), __uint_as_float(rr_[1])); } \
        const float rel = FOX ? mx : mx - m_run; const bool first = ((jj) == 0 && HALF == 0); \
        if (__any(first || rel > 8.0f)) { const float delta = first ? rel : __builtin_fmaxf(rel, 0.f); m_run += delta; const float alpha = first ? 1.0f : __builtin_amdgcn_exp2f(-delta); l_run *= alpha; \
            _Pragma("unroll") for (int d = 0; d < NDB; ++d) _Pragma("unroll") for (int r = 0; r < 16; ++r) o[d][r] *= alpha; \
            if (FOX) { osum[0] *= alpha; _Pragma("unroll") for (int r = 0; r < 16; ++r) { P[r] -= delta; if (HAVE_OTHER) PO[r] -= delta; } } } \
        float sum = 0.f; \
        _Pragma("unroll") for (int r = 0; r < 16; ++r) { P[r] = __builtin_amdgcn_exp2f(FOX ? P[r] : P[r] - m_run); if (!FOX) sum += P[r]; } \
        l_run += sum; \
        u32x4 w0, w1; \
        w0.x = cvtpk(P[0], P[1]); w0.y = cvtpk(P[2], P[3]); w0.z = cvtpk(P[4], P[5]); w0.w = cvtpk(P[6], P[7]); \
        w1.x = cvtpk(P[8], P[9]); w1.y = cvtpk(P[10], P[11]); w1.z = cvtpk(P[12], P[13]); w1.w = cvtpk(P[14], P[15]); \
        const bf16x8 pk0 = __builtin_bit_cast(bf16x8, w0), pk1 = __builtin_bit_cast(bf16x8, w1); \
        if (FOX) { osum = __builtin_amdgcn_mfma_f32_32x32x16_bf16(vones, pk0, osum, 0, 0, 0); osum = __builtin_amdgcn_mfma_f32_32x32x16_bf16(vones, pk1, osum, 0, 0, 0); } \
        _Pragma("unroll") for (int d = 0; d < NDB; ++d) { const s16x4 lo = vtr(Vb + vlo[0] + vdo[d] + (32 * HALF) * C::VRB), h8 = vtr(Vb + vlo[1] + vdo[d] + (32 * HALF) * C::VRB); \
            const bf16x8 vf = {lo[0], lo[1], lo[2], lo[3], h8[0], h8[1], h8[2], h8[3]}; o[d] = __builtin_amdgcn_mfma_f32_32x32x16_bf16(vf, pk0, o[d], 0, 0, 0); } \
        _Pragma("unroll") for (int d = 0; d < NDB; ++d) { const s16x4 lo = vtr(Vb + vlo[0] + vdo[d] + (32 * HALF + 16) * C::VRB), h8 = vtr(Vb + vlo[1] + vdo[d] + (32 * HALF + 16) * C::VRB); \
            const bf16x8 vf = {lo[0], lo[1], lo[2], lo[3], h8[0], h8[1], h8[2], h8[3]}; o[d] = __builtin_amdgcn_mfma_f32_32x32x16_bf16(vf, pk1, o[d], 0, 0, 0); } \
    } while (0)
#define ATT_SPV(jj, boff, sub) do { const LAS unsigned char* Vb_ = lds + (boff) + C::KT + (sub) * 64 * C::VRB; ATT_HALF(p0, p1, 0, true, jj, Vb_); ATT_HALF(p1, p0, 1, false, jj, Vb_); } while (0)
    int bcur = 0, bnext = C::BUF;
    const int NTT = NT / C::SUBS;
    for (int jt = 0; jt < NTT; ++jt) {
        if (jt + 1 < NTT) ATT_ISSUE(jt + 1, bnext);
#pragma unroll
        for (int sub = 0; sub < C::SUBS; ++sub) {
            const int j = jt * C::SUBS + sub;
            const bool act = (j <= jdiag);
            if (act) ATT_SCORES(j, bcur, sub);
            if (!FOX && odd) ATT_WAIT(0);
            if (act) ATT_SPV(j, bcur, sub);
            if (FOX && odd && sub == 0) ATT_WAIT(0);
        }
        if (!odd) ATT_WAIT(0);
        bcur = bnext; bnext += C::BUF; if (bnext == C::TOTAL) bnext = 0;
    }
    ATT_WAIT(0);
#undef ATT_SCORES
#undef ATT_HALF
#undef ATT_SPV
#undef ATT_ISSUE
    if (FOX) l_run = osum[0];
    { auto rr_ = __builtin_amdgcn_permlane32_swap(__float_as_uint(l_run), __float_as_uint(l_run), false, false); l_run = __uint_as_float(rr_[0]) + __uint_as_float(rr_[1]); }
    const float inv = 1.0f / l_run;
    constexpr int SRB = DV * 2 + 16, CPR = DV / 8, RPI = 64 / CPR;
    LAS unsigned char* stg = lds + C::BUF + wid * (32 * SRB);
#pragma unroll
    for (int d = 0; d < NDB; ++d)
#pragma unroll
        for (int rg = 0; rg < 4; ++rg) { u32x2 w; w.x = cvtpk(o[d][4 * rg] * inv, o[d][4 * rg + 1] * inv); w.y = cvtpk(o[d][4 * rg + 2] * inv, o[d][4 * rg + 3] * inv);
            *(LAS u32x2*)(stg + r32 * SRB + (d * 32 + 8 * rg + 4 * hi) * 2) = w; }
    asm volatile("s_waitcnt lgkmcnt(0)" ::: "memory");
    bf16_t* ob = dry ? (bf16_t*)wsb + ((FOX ? 256 : 28) * MiB / 2) + (size_t)(32 * wid) * opitch + h * ohw : O + (rowbase + q0 + 32 * wid) * opitch + h * ohw;
#pragma unroll
    for (int it = 0; it < 32 / RPI; ++it) { const int row = it * RPI + lane / CPR, ch = lane % CPR;
        const u32x4 v = *(const LAS u32x4*)(stg + row * SRB + ch * 16);
        *(u32x4*)(ob + (size_t)row * opitch + ch * 8) = v; }
}

template <int DQK, int DV, bool FOX, class F>
__device__ __forceinline__ void attn_phase(int G, int bx, F&& run) {
    if (G == 256) { const int vcu = (bx & 7) * 32 + (bx >> 3); const int bh = vcu >> 2, s = vcu & 3;
        for (int i = 0; i < 8; ++i) { const int qb = (i & 1) ? (8 * (i >> 1) + 7 - s) : (8 * (i >> 1) + s); run(bh >> 4, bh & 15, 31 - qb); }
    } else { for (int L = bx; L < 2048; L += G) run(L >> 9, (L >> 5) & 15, 31 - (L & 31)); }
}
}

#define XB_TMO      128
#define XB_XCNT(j)  (256  + 64 * (j))
#define XB_XSUB(j)  (1280 + 64 * (j))
#define XB_XGEN(j)  (2304 + 64 * (j))
#define XB_TOP      3328
#define XB_TOPGEN   3392
#define XCD_BAR_WORDS 3456
#define XB_SPIN_CAP (1u << 18)

__device__ __forceinline__ unsigned xb_ld(unsigned* p)              { return __hip_atomic_load(p, __ATOMIC_RELAXED, __HIP_MEMORY_SCOPE_AGENT); }
__device__ __forceinline__ unsigned xb_add(unsigned* p, unsigned v) { return __hip_atomic_fetch_add(p, v, __ATOMIC_RELAXED, __HIP_MEMORY_SCOPE_AGENT); }
__device__ __forceinline__ unsigned xb_xcc_id() { return (unsigned)__builtin_amdgcn_s_getreg((3 << 11) | 20) & 0xFu; }
#define XB_SPIN(cond, bar) do { unsigned _sp = 0; while (cond) { __builtin_amdgcn_s_sleep(1); \
    if ((++_sp & 255u) == 0u) { if (xb_ld(&(bar)[XB_TMO])) break; if (_sp > XB_SPIN_CAP) { atomicAdd(&(bar)[XB_TMO], 1u); break; } } } } while (0)

struct XcdBarrier {
    unsigned* bar; unsigned x;
    volatile LAS unsigned* st;
};

__device__ __forceinline__ XcdBarrier xcd_barrier_post(unsigned* bar, volatile LAS unsigned* st) {
    XcdBarrier b; b.bar = bar; b.x = xb_xcc_id(); b.st = st;
    if (threadIdx.x == 0) (void)xb_add(&bar[XB_XCNT(b.x)], 1u);
    return b;
}
__device__ __forceinline__ void xcd_barrier_complete(unsigned* bar, unsigned x, unsigned& nloc, unsigned& nx) {
    const unsigned G = gridDim.x * gridDim.y * gridDim.z;
    unsigned sum, cnt, mine, sp = 0u;
    for (;;) {
        sum = 0u; cnt = 0u; mine = 0u;
#pragma unroll
        for (unsigned j = 0; j < 16; ++j) { const unsigned c = xb_ld(&bar[XB_XCNT(j)]); sum += c; cnt += (c > 0u) ? 1u : 0u; mine = (j == x) ? c : mine; }
        if (sum == G) break;
        __builtin_amdgcn_s_sleep(1);
        if ((++sp & 255u) == 0u) { if (xb_ld(&bar[XB_TMO])) break; if (sp > XB_SPIN_CAP) { atomicAdd(&bar[XB_TMO], 1u); break; } }
    }
    nloc = mine > 0u ? mine : 1u; nx = cnt > 0u ? cnt : 1u;
}

__device__ __forceinline__ void xcd_barrier(const XcdBarrier& b) {
    asm volatile("s_waitcnt vmcnt(0)" ::: "memory");
    __syncthreads();
    if (threadIdx.x == 0) {
        unsigned* bar = b.bar;
        __builtin_amdgcn_s_waitcnt(0);
        unsigned nloc = b.st[0], nx = b.st[1];
        if (nloc == 0u) { xcd_barrier_complete(bar, b.x, nloc, nx); b.st[0] = nloc; b.st[1] = nx; }
        const unsigned old = xb_add(&bar[XB_XSUB(b.x)], 1u);
        const unsigned gen = old / nloc;
        if (old + 1u == (gen + 1u) * nloc) {
            __builtin_amdgcn_fence(__ATOMIC_RELEASE, "agent");
            asm volatile("s_waitcnt vmcnt(0)" ::: "memory");
            const unsigned og = xb_add(&bar[XB_TOP], 1u);
            const unsigned tg = og / nx;
            if (og + 1u == (tg + 1u) * nx) xb_add(&bar[XB_TOPGEN], 1u);
            else XB_SPIN(xb_ld(&bar[XB_TOPGEN]) == tg, bar);
            __builtin_amdgcn_fence(__ATOMIC_ACQUIRE, "agent");
            xb_add(&bar[XB_XGEN(b.x)], 1u);
            asm volatile("s_waitcnt vmcnt(0)" ::: "memory");
        } else {
            XB_SPIN(xb_ld(&bar[XB_XGEN(b.x)]) == gen, bar);
            __builtin_amdgcn_fence(__ATOMIC_ACQUIRE, "agent");
            asm volatile("s_waitcnt vmcnt(0)" ::: "memory");
        }
    }
    __syncthreads();
}

constexpr int NPHASE = 14;
struct Args { const float* in[21]; float* out; unsigned char* ws; int ph_lo, ph_hi, probe, pad; };

__global__ void __launch_bounds__(512, 2) mega_fwd(Args a) {
    extern __shared__ __attribute__((aligned(16))) unsigned char lds_raw[];
    LAS unsigned char* lds = (LAS unsigned char*)lds_raw;
    cg::grid_group grid = cg::this_grid();
    P p;
    p.x = a.in[0]; p.fox_norm = a.in[1]; p.w_fox_in = a.in[2]; p.b_fox_f = a.in[3]; p.w_fox_out = a.in[4]; p.kv_in_norm = a.in[5]; p.w_dkv = a.in[6]; p.kv_norm = a.in[7];
    p.w_uk = a.in[8]; p.w_uv = a.in[9]; p.mla_norm = a.in[10]; p.w_dq = a.in[11]; p.q_norm = a.in[12]; p.w_uq = a.in[13]; p.w_mla_out = a.in[14]; p.ffn_norm = a.in[15];
    p.w_ffn_in = a.in[16]; p.ffn_conv_w = a.in[17]; p.ffn_conv_b = a.in[18]; p.w_ffn_out = a.in[19]; p.final_norm = a.in[20]; p.out = a.out; p.ws = a.ws;
    unsigned char* ws = a.ws;
    const int tid = threadIdx.x, wave = tid >> 6, G = gridDim.x, bx = blockIdx.x;
    const int gw = bx * 8 + wave, NGW = G * 8, gtid = bx * 512 + tid, NGT = G * 512;
    const int lo = a.ph_lo, hi = a.ph_hi;
    volatile LAS unsigned* bst = (volatile LAS unsigned*)(lds + LDS_MISC + 2048);
    if (tid < 2) bst[tid] = 0u;
    __syncthreads();
    XcdBarrier bar = xcd_barrier_post((unsigned*)ws, bst);
#ifndef PHMASK
#define PHMASK 0xffff
#endif
#define IN(k) (((PHMASK >> (k)) & 1) && lo <= (k) && (k) < hi)
#define SEAM(k) do { if (IN(k) && IN((k) + 1)) { if ((k) == 0) grid.sync(); else xcd_barrier(bar); } } while (0)
    bf16_t* XB = (bf16_t*)(ws + WS_XB);
    float* SSQ1 = (float*)(ws + WS_SSQ1); float* SSQ2 = (float*)(ws + WS_SSQ2); float* SSQ3 = (float*)(ws + WS_SSQ3); float* SSQQ = (float*)(ws + WS_SSQQ); float* SSQL = (float*)(ws + WS_SSQL);
    const f32x4* ROPE = (const f32x4*)(ws + WS_ROPE);

    if (IN(0)) { phase_prologue(p, lds, gw, NGW, gtid, NGT, 3);
#if (MK_PROBE & 3)
        __syncthreads(); phase_prologue(p, lds, gw, NGW, gtid, NGT, a.probe & 3);
#endif
    }
    SEAM(0);
    if (IN(1)) {
        for (int c = bx; c < 128; c += G) chunk_scan(p, lds, c);
        pg8::Gemm g{XB, (const bf16_t*)(ws + WS_WQKV), M, 3072, 1024, 1024}; pg8::StaticOrder S; S.init(M, 3072, G, bx);
        epi::RowScaleSplit E{(bf16_t*)(ws + WS_Q0), 1024, 1024, (size_t)(WS_K0 - WS_Q0) / 2, C2F, (const float*)(ws + WS_RSTD0), 0.f, 1};
        pg8::gemm_phase<epi::RowScaleSplit, pg8::StaticOrder, true, true>(lds, g, S, E);
    }
    SEAM(1);
    if (IN(2)) {
        const bf16_t* Qp = (const bf16_t*)(ws + WS_Q0); const bf16_t* Kp = (const bf16_t*)(ws + WS_K0); const bf16_t* Vp = (const bf16_t*)(ws + WS_V0);
        const float* cumT = (const float*)(ws + WS_CUMT); const float* ctot = (const float*)(ws + WS_CTOT);
#if (MK_PROBE >> 2) & 1
        { const bool dry = a.probe != 0;
        att::attn_phase<64, 64, true>(G, bx, [&](int b, int h, int qb) {
            att::attn_unit<64, 64, true>(lds, b, h, qb, Qp, 1024, Kp, 1024, 64, nullptr, Vp, 1024, (bf16_t*)(ws + WS_Q0), 1024, 64, cumT, ctot, (const bf16_t*)ws, dry); }); }
#endif
        att::attn_phase<64, 64, true>(G, bx, [&](int b, int h, int qb) {
            att::attn_unit<64, 64, true>(lds, b, h, qb, Qp, 1024, Kp, 1024, 64, nullptr, Vp, 1024, (bf16_t*)(ws + WS_Q0), 1024, 64, cumT, ctot, (const bf16_t*)ws, false); });
    }
    SEAM(2);
    if (IN(3)) {
        pg8::Gemm g{(const bf16_t*)(ws + WS_Q0), (const bf16_t*)(ws + WS_WFO), M, 1024, 1024, 1024}; pg8::StaticOrder S; S.init(M, 1024, G, bx);
        epi::Residual E{p.x, p.out, XB, SSQ1};
        pg8::gemm_phase<epi::Residual, pg8::StaticOrder, true, true>(lds, g, S, E);
    }
    SEAM(3);
    if (IN(4)) {
        pg8::Gemm g{XB, (const bf16_t*)(ws + WS_WFI0), M, NFF2, 1024, 1024}; ConvOrder S{G, bx};
        epi::ConvGate E{(bf16_t*)(ws + WS_G), SSQ1, p.ffn_conv_w, p.ffn_conv_b, (LAS f32x4*)(lds + LDS_XCH)};
        pg8::gemm_phase<epi::ConvGate, ConvOrder, true, true>(lds, g, S, E);
    }
    SEAM(4);
    if (IN(5)) {
        pg8::Gemm g{(const bf16_t*)(ws + WS_G), (const bf16_t*)(ws + WS_WFD0), M, 1024, DFF, DFF}; pg8::StaticOrder S; S.init(M, 1024, G, bx);
        epi::Residual E{p.out, p.out, XB, SSQ2};
        pg8::gemm_phase<epi::Residual, pg8::StaticOrder, true, true>(lds, g, S, E);
    }
    SEAM(5);
    if (IN(6)) {
        pg8::Gemm g{XB, (const bf16_t*)(ws + WS_WDN), M, 1280, 1024, 1024}; pg8::StaticOrder S; S.init(M, 1280, G, bx);
        epi::MlaDown E{SSQ2, (bf16_t*)(ws + WS_CQ), (bf16_t*)(ws + WS_LAT), (bf16_t*)(ws + WS_KR), SSQQ, SSQL, ROPE};
        pg8::gemm_phase<epi::MlaDown, pg8::StaticOrder, true, true>(lds, g, S, E);
    }
    SEAM(6);
    if (IN(7)) {
        pg8::Gemm g{(const bf16_t*)(ws + WS_CQ), (const bf16_t*)(ws + WS_WUQ), M, 3072, 768, 768}; pg8::StaticOrder S; S.init(M, 3072, G, bx);
        epi::MlaUq E{SSQQ, (bf16_t*)(ws + WS_QM), ROPE};
        pg8::gemm_phase<epi::MlaUq, pg8::StaticOrder, true, true>(lds, g, S, E);
    }
    SEAM(7);
    if (IN(8)) {
        pg8::Gemm g{(const bf16_t*)(ws + WS_LAT), (const bf16_t*)(ws + WS_WUKV), M, 4096, 256, 256}; pg8::StaticOrder S; S.init(M, 4096, G, bx);
        epi::RowScaleSplit E{(bf16_t*)(ws + WS_KN), 2048, 2048, (size_t)(WS_VM - WS_KN) / 2, 1.f, SSQL, 1.0f / 256.0f, 0};
        pg8::gemm_phase<epi::RowScaleSplit, pg8::StaticOrder, true, true>(lds, g, S, E);
    }
    SEAM(8);
    if (IN(9)) {
        const bf16_t* Qp = (const bf16_t*)(ws + WS_QM); const bf16_t* Kp = (const bf16_t*)(ws + WS_KN); const bf16_t* Krp = (const bf16_t*)(ws + WS_KR); const bf16_t* Vp = (const bf16_t*)(ws + WS_VM);
#if (MK_PROBE >> 9) & 1
        { const bool dry = a.probe != 0;
        att::attn_phase<192, 128, false>(G, bx, [&](int b, int h, int qb) {
            att::attn_unit<192, 128, false>(lds, b, h, qb, Qp, 3072, Kp, 2048, 128, Krp, Vp, 2048, (bf16_t*)(ws + WS_QM), 3072, 192, nullptr, nullptr, (const bf16_t*)ws, dry); }); }
#endif
        att::attn_phase<192, 128, false>(G, bx, [&](int b, int h, int qb) {
            att::attn_unit<192, 128, false>(lds, b, h, qb, Qp, 3072, Kp, 2048, 128, Krp, Vp, 2048, (bf16_t*)(ws + WS_QM), 3072, 192, nullptr, nullptr, (const bf16_t*)ws, false); });
    }
    SEAM(9);
    if (IN(10)) {
        pg8::Gemm g{(const bf16_t*)(ws + WS_QM), (const bf16_t*)(ws + WS_WMO), M, 1024, 2048, 3072}; pg8::StaticOrder S; S.init(M, 1024, G, bx);
        epi::Residual E{p.out, p.out, XB, SSQ3};
        pg8::gemm_phase<epi::Residual, pg8::StaticOrder, true, true, 1>(lds, g, S, E);
    }
    SEAM(10);
    if (IN(11)) {
        pg8::Gemm g{XB, (const bf16_t*)(ws + WS_WFI1), M, NFF2, 1024, 1024}; ConvOrder S{G, bx};
        epi::ConvGate E{(bf16_t*)(ws + WS_G), SSQ3, p.ffn_conv_w + 3 * NFF2, p.ffn_conv_b + NFF2, (LAS f32x4*)(lds + LDS_XCH)};
        pg8::gemm_phase<epi::ConvGate, ConvOrder, true, true>(lds, g, S, E);
    }
    SEAM(11);
    if (IN(12)) {
        pg8::Gemm g{(const bf16_t*)(ws + WS_G), (const bf16_t*)(ws + WS_WFD1), M, 1024, DFF, DFF}; pg8::StaticOrder S; S.init(M, 1024, G, bx);
        epi::Residual E{p.out, p.out, nullptr, nullptr};
        pg8::gemm_phase<epi::Residual, pg8::StaticOrder, true, true>(lds, g, S, E);
    }
    SEAM(12);
    if (IN(13)) { phase_final(p, gw, NGW); }
#undef IN
#undef SEAM
}

#ifndef MK_COOP
#define MK_COOP 1
#endif
extern "C" void kernel_launch(void* const* d_in, const int* in_sizes, int n_in, void* d_out, int out_size, void* d_ws, size_t ws_size, hipStream_t stream) {
    static int grid = 0;
    if (grid == 0) {
        if (n_in != 21 || in_sizes[0] != M * DM || out_size != M * DM || ws_size < WS_END) { fprintf(stderr, "kernel_launch: unexpected shapes (n_in %d, in0 %d, out %d, ws %zu)\n", n_in, n_in > 0 ? in_sizes[0] : -1, out_size, ws_size); grid = -1; return; }
        int dev = 0, cus = 0, per_cu = 0;
        hipGetDevice(&dev); hipDeviceGetAttribute(&cus, hipDeviceAttributeMultiprocessorCount, dev);
        if (hipFuncSetAttribute((const void*)mega_fwd, hipFuncAttributeMaxDynamicSharedMemorySize, LDS_BYTES) != hipSuccess) { fprintf(stderr, "kernel_launch: hipFuncSetAttribute failed\n"); grid = -1; return; }
        if (hipOccupancyMaxActiveBlocksPerMultiprocessor(&per_cu, (const void*)mega_fwd, 512, LDS_BYTES) != hipSuccess || per_cu < 1) { fprintf(stderr, "kernel_launch: occupancy query says %d\n", per_cu); per_cu = 1; }
        (void)hipGetLastError();
        grid = cus * per_cu;
    }
    if (grid < 0) return;
    if (hipMemsetAsync(d_ws, 0, 16384, stream) != hipSuccess) { fprintf(stderr, "kernel_launch: memset failed\n"); return; }
    Args a{};
    for (int i = 0; i < 21; ++i) a.in[i] = (const float*)d_in[i];
    a.out = (float*)d_out; a.ws = (unsigned char*)d_ws; a.probe = MK_PROBE;
#if MK_COOP
    a.ph_lo = 0; a.ph_hi = NPHASE;
    void* args[] = {&a};
    hipError_t e = hipLaunchCooperativeKernel((const void*)mega_fwd, dim3(grid), dim3(512), args, LDS_BYTES, stream);
    if (e != hipSuccess) fprintf(stderr, "cooperative launch failed: %s (grid %d)\n", hipGetErrorString(e), grid);
#else
    for (int ph = 0; ph < NPHASE; ++ph) { a.ph_lo = ph; a.ph_hi = ph + 1; hipLaunchKernelGGL(mega_fwd, dim3(grid), dim3(512), LDS_BYTES, stream, a); }
#endif
}
```
